# Optimizing an MI355X kernel written in HIP

```python
import math
import jax, jax.numpy as jnp
from jax import lax
import numpy as np

D_MODEL = 2048
BATCH = 4
SEQ = 4096
DEPTH = 2

N_MIXERS = 2
HEAD_DIM = 128
N_MIX_HEADS = (3 * D_MODEL) // (4 * HEAD_DIM)
MIX_WIDTH = N_MIX_HEADS * HEAD_DIM
N_MEM_HEADS = 4
MEM_WIDTH = N_MEM_HEADS * HEAD_DIM
MEM_TOKENS = 256
IN_WIDTH = 3 * MIX_WIDTH + MEM_WIDTH
OUT_WIDTH = MIX_WIDTH + MEM_WIDTH
D_FF = 4 * D_MODEL
DIFF_HALF = HEAD_DIM // 2
DILATED_GROUPS = ((128, 1), (512, 4), (2048, 16))
HEADS_PER_GROUP = N_MIX_HEADS // len(DILATED_GROUPS)
QBLOCK = 128
NORM_EPS = 1e-6

kernel_name = "hybrid_diffattn_dilated_memory_block"


def _alibi_slopes(n):
    def pow2(m):
        start = 2.0 ** (-(2.0 ** -(math.log2(m) - 3)))
        return [start * start ** i for i in range(m)]
    def slopes(m):
        if math.log2(m).is_integer():
            return pow2(m)
        c = 2 ** math.floor(math.log2(m))
        return pow2(c) + slopes(2 * c)[0::2][: m - c]
    return jnp.asarray(sorted(slopes(n), reverse=True), dtype=jnp.float32)


def _rmsnorm(x, g):
    xf = x.astype(jnp.float32)
    y = xf * lax.rsqrt(jnp.mean(xf * xf, axis=-1, keepdims=True) + NORM_EPS)
    return (y * g.astype(jnp.float32)).astype(x.dtype)


def _heads(t, n_heads):
    b, s, _ = t.shape
    return t.reshape(b, s, n_heads, -1).transpose(0, 2, 1, 3)


def _diff_attention(q1, q2, k1, k2, v, lam, slopes):
    b, h, s, d = q1.shape
    scale = d ** -0.5
    kpos = jnp.arange(s)
    def block(i):
        q0 = i * QBLOCK
        qa = lax.dynamic_slice_in_dim(q1, q0, QBLOCK, axis=2)
        qb = lax.dynamic_slice_in_dim(q2, q0, QBLOCK, axis=2)
        dist = (q0 + jnp.arange(QBLOCK))[:, None] - kpos[None, :]
        bias = jnp.where(dist >= 0, -slopes[:, None, None] * dist.astype(jnp.float32), -jnp.inf)
        s1 = jnp.einsum('bhqd,bhkd->bhqk', qa, k1, preferred_element_type=jnp.float32) * scale + bias
        s2 = jnp.einsum('bhqd,bhkd->bhqk', qb, k2, preferred_element_type=jnp.float32) * scale + bias
        a = (jax.nn.softmax(s1, axis=-1) - lam * jax.nn.softmax(s2, axis=-1)).astype(v.dtype)
        return jnp.einsum('bhqk,bhkd->bhqd', a, v)
    out = lax.map(block, jnp.arange(s // QBLOCK))
    return out.transpose(1, 2, 0, 3, 4).reshape(b, h, s, v.shape[-1])


def _dilated_group(q, k, v, window, dilation, slopes):
    b, h, s, dh = q.shape
    n_keys = window // dilation + 1
    offs = jnp.arange(n_keys) * dilation
    scale = dh ** -0.5
    bias = -slopes[:, None, None] * offs.astype(jnp.float32)[None, None, :]
    def block(i):
        q0 = i * QBLOCK
        qb = lax.dynamic_slice_in_dim(q, q0, QBLOCK, axis=2)
        kidx = (q0 + jnp.arange(QBLOCK))[:, None] - offs[None, :]
        valid = kidx >= 0
        kidx = jnp.maximum(kidx, 0)
        kb = k[:, :, kidx]
        vb = v[:, :, kidx]
        sc = jnp.einsum('bhqd,bhqjd->bhqj', qb, kb, preferred_element_type=jnp.float32) * scale + bias
        sc = jnp.where(valid, sc, -jnp.inf)
        lse = jax.nn.logsumexp(sc, axis=-1)
        p = jnp.exp(sc - lse[..., None]).astype(v.dtype)
        return jnp.einsum('bhqj,bhqjd->bhqd', p, vb), lse
    o, lse = lax.map(block, jnp.arange(s // QBLOCK))
    o = o.transpose(1, 2, 0, 3, 4).reshape(b, h, s, dh)
    lse = lse.transpose(1, 2, 0, 3).reshape(b, h, s)
    return o, lse


def _dilated_attention(q, k, v, slopes):
    outs, lses = [], []
    for g, (window, dilation) in enumerate(DILATED_GROUPS):
        sl = slice(g * HEADS_PER_GROUP, (g + 1) * HEADS_PER_GROUP)
        o, lse = _dilated_group(q[:, sl], k[:, sl], v[:, sl], window, dilation, slopes[sl])
        outs.append(o)
        lses.append(lse)
    alpha = jax.nn.softmax(jnp.stack(lses, axis=0), axis=0)
    return jnp.concatenate([o * alpha[g][..., None].astype(o.dtype) for g, o in enumerate(outs)], axis=1)


def _memory_attention(qm, km, vm):
    sc = jnp.einsum('bhqd,bhmd->bhqm', qm, km, preferred_element_type=jnp.float32) * (qm.shape[-1] ** -0.5)
    p = jax.nn.softmax(sc, axis=-1).astype(vm.dtype)
    return jnp.einsum('bhqm,bhmd->bhqd', p, vm)


def setup_inputs(seed: int = 0) -> dict:
    key = jax.random.key(seed)
    ks = jax.random.split(key, 14)
    n_diff = (DEPTH + N_MIXERS - 1) // N_MIXERS
    f32 = jnp.float32
    def nrm(k, shape, scale):
        return jax.random.normal(k, shape, f32) * scale
    return {
        "x": nrm(ks[0], (BATCH, SEQ, D_MODEL), 1.0),
        "mem": nrm(ks[1], (BATCH, MEM_TOKENS, D_MODEL), 1.0),
        "g_attn": 1.0 + nrm(ks[2], (DEPTH, D_MODEL), 0.02),
        "w_in": nrm(ks[3], (DEPTH, D_MODEL, IN_WIDTH), D_MODEL ** -0.5),
        "w_out": nrm(ks[4], (DEPTH, OUT_WIDTH, D_MODEL), OUT_WIDTH ** -0.5),
        "lambda_qk": nrm(ks[5], (n_diff, 4, DIFF_HALF), 0.1),
        "diff_subln_g": 1.0 + nrm(ks[6], (n_diff, HEAD_DIM), 0.02),
        "g_mem": 1.0 + nrm(ks[7], (D_MODEL,), 0.02),
        "w_mem_kv": nrm(ks[8], (DEPTH, D_MODEL, 2 * MEM_WIDTH), D_MODEL ** -0.5),
        "g_mlp": 1.0 + nrm(ks[9], (DEPTH, D_MODEL), 0.02),
        "w_mlp1": nrm(ks[10], (DEPTH, D_MODEL, D_FF), D_MODEL ** -0.5),
        "w_mlp2": nrm(ks[11], (DEPTH, D_FF, D_MODEL), D_FF ** -0.5),
        "g_final": 1.0 + nrm(ks[12], (D_MODEL,), 0.02),
    }


def reference(x, mem, g_attn, w_in, w_out, lambda_qk, diff_subln_g, g_mem, w_mem_kv,
              g_mlp, w_mlp1, w_mlp2, g_final):
    b, s, d_model = x.shape
    slopes = _alibi_slopes(N_MIX_HEADS)
    memn = _rmsnorm(mem, g_mem)
    for i in range(DEPTH):
        h = _rmsnorm(x, g_attn[i])
        proj = h @ w_in[i]
        q, k, v, qm = jnp.split(proj, [MIX_WIDTH, 2 * MIX_WIDTH, 3 * MIX_WIDTH], axis=-1)
        q, k, v = _heads(q, N_MIX_HEADS), _heads(k, N_MIX_HEADS), _heads(v, N_MIX_HEADS)
        if i % N_MIXERS == 0:
            j = i // N_MIXERS
            lam_init = 0.8 - 0.6 * math.exp(-0.3 * i)
            lp = lambda_qk[j].astype(jnp.float32)
            lam = jnp.exp(jnp.sum(lp[0] * lp[1])) - jnp.exp(jnp.sum(lp[2] * lp[3])) + lam_init
            o = _diff_attention(q[..., :DIFF_HALF], q[..., DIFF_HALF:],
                                k[..., :DIFF_HALF], k[..., DIFF_HALF:], v, lam, slopes)
            o = _rmsnorm(o, diff_subln_g[j]) * (1.0 - lam_init)
        else:
            o = _dilated_attention(q, k, v, slopes)
        km, vm = jnp.split(memn @ w_mem_kv[i], 2, axis=-1)
        om = _memory_attention(_heads(qm, N_MEM_HEADS), _heads(km, N_MEM_HEADS), _heads(vm, N_MEM_HEADS))
        heads = jnp.concatenate([o, om], axis=1)
        merged = heads.transpose(0, 2, 1, 3).reshape(b, s, OUT_WIDTH)
        x = x + merged @ w_out[i]
        hm = _rmsnorm(x, g_mlp[i])
        x = x + jnp.square(jax.nn.relu(hm @ w_mlp1[i])) @ w_mlp2[i]
    return _rmsnorm(x, g_final)
```

```cpp
#include <hip/hip_runtime.h>
#include <hip/hip_cooperative_groups.h>
#include <cstdio>
#include <cstdint>
namespace cg = cooperative_groups;

#define LAS __attribute__((address_space(3)))
typedef unsigned short bf16_t;
typedef short bf16x8 __attribute__((ext_vector_type(8)));
typedef float f32x4 __attribute__((ext_vector_type(4)));
typedef float f32x16 __attribute__((ext_vector_type(16)));
typedef unsigned u32x4 __attribute__((ext_vector_type(4)));
typedef unsigned u32x2 __attribute__((ext_vector_type(2)));
typedef unsigned long long u64;

constexpr int NB = 4, SEQ = 4096, MTOK = NB * SEQ, DM = 2048, NH = 12, HD = 128, MIXW = 1536, MEMW = 512, INW = 5120, FF = 8192, MEMT = 256;
constexpr int QKW = 3584;
constexpr float LOG2E = 1.4426950408889634f;
constexpr float EPS = 1e-6f;
constexpr float SSQ_FIX = 16777216.0f;

constexpr size_t MiB = 1u << 20;
constexpr size_t WS_CTL = 0;
constexpr size_t CTL_BYTES = 1 * MiB;
constexpr size_t SSQ_OFF = 64 * 1024;
constexpr size_t WS_LSE = 1 * MiB;
constexpr size_t WS_KM = 4 * MiB;
constexpr size_t WS_WIN = 8 * MiB, WS_WOUT = 28 * MiB, WS_W1 = 36 * MiB, WS_W2 = 68 * MiB;
constexpr size_t WS_XB = 100 * MiB;
constexpr size_t WS_BIG = 164 * MiB;
constexpr size_t WS_QK = WS_BIG, WS_VT = WS_BIG + 112 * MiB, WS_MRG = WS_BIG + 160 * MiB;
constexpr size_t WS_WL1 = 412 * MiB;
constexpr size_t WS_END = 512 * MiB;

__device__ __forceinline__ unsigned cvt_pk_bf16(float lo, float hi) { unsigned r; asm("v_cvt_pk_bf16_f32 %0, %1, %2" : "=v"(r) : "v"(lo), "v"(hi)); return r; }
__device__ __forceinline__ float bf_lo(unsigned w) { return __uint_as_float(w << 16); }
__device__ __forceinline__ float bf_hi(unsigned w) { return __uint_as_float(w & 0xffff0000u); }
__device__ __forceinline__ float wave_sum(float v) {
#pragma unroll
    for (int o = 1; o < 64; o <<= 1) v += __shfl_xor(v, o);
    return v;
}
__device__ __forceinline__ float swap32(float v) { return __shfl_xor(v, 32); }
__device__ __forceinline__ float rstd_of(u64 s) { return rsqrtf((float)s * (1.0f / (SSQ_FIX * (float)DM)) + EPS); }

namespace pg8 {
constexpr int BM = 256, BK = 64, HALF = 128, HTB = HALF * BK * 2, STAGE_BYTES = 8 * HTB;
__device__ __forceinline__ int lds_byte(int r, int c) { const int st = (r >> 4) * 2 + (c >> 5), rr = r & 15, cc = c & 31, ob = rr * 64 + cc * 2; return st * 1024 + (ob ^ (((ob >> 9) & 1) << 5)); }
__device__ __forceinline__ void stage_rc(int b, int& R, int& C) { const int st = b / 1024, sb = b % 1024, swz = sb ^ (((sb >> 9) & 1) << 5); R = (st >> 1) * 16 + swz / 64; C = (st & 1) * 32 + (swz % 64) / 2; }
__device__ __forceinline__ int perm32(int rho) { const int n = rho >> 4, i = rho & 15; return 8 * (i >> 2) + 4 * n + (i & 3); }

struct Unit { int pm, pn, kind, bstr, brow; const char* a; const char* b; };

template <class Epi, class Sched>
__device__ __forceinline__ void gemm_phase(LAS unsigned char* lds, const int K, const Sched& S, const Epi& E) {
    int tid = threadIdx.x; asm volatile("" : "+v"(tid));
    const int wid = __builtin_amdgcn_readfirstlane(tid >> 6), lane = tid & 63, wr = wid >> 2, wc = wid & 3, fr = lane & 15, fq = lane >> 4;
    const int nt = K / BK;
    unsigned voffA[2];
#pragma unroll
    for (int i = 0; i < 2; ++i) { int R, C; stage_rc(tid * 16 + i * 8192, R, C); voffA[i] = (unsigned)(R * K + C) * 2u; }
#define PG8_VOFFB(dst, bstr_) do { int tt_ = tid; asm volatile("" : "+v"(tt_)); _Pragma("unroll") for (int i = 0; i < 2; ++i) { int R, C; stage_rc(tt_ * 16 + i * 8192, R, C); \
        const int Rb = (R & ~31) + perm32(R & 31); dst[i] = (unsigned)(Rb * K * (bstr_) + C) * 2u; } } while (0)
    const size_t kstep = (size_t)(BK * 2);
    const size_t hstepA = (size_t)HALF * K * 2;
    const unsigned ldsw = (unsigned)wid * 1024u;
    const int aoff = lds_byte(wr * 64 + fr, fq * 8), boff = lds_byte(wc * 32 + fr, fq * 8);
#define PG8_SA(b, h) (((b) * 2 + (h)) * HTB)
#define PG8_SB(b, h) ((4 + (b) * 2 + (h)) * HTB)
#define PG8_STAGE(bufoff, gbase, voff) do { _Pragma("unroll") for (int _i = 0; _i < 2; ++_i) \
        __builtin_amdgcn_global_load_lds((const unsigned*)((const char*)(gbase) + (voff)[_i]), (LAS unsigned*)(lds + (bufoff) + ldsw + _i * 8192), 16, 0, 0); } while (0)
#define PG8_LDA(dst, b, h) do { _Pragma("unroll") for (int m = 0; m < 4; ++m) _Pragma("unroll") for (int k = 0; k < 2; ++k) dst[m][k] = *(const LAS bf16x8*)(lds + PG8_SA(b, h) + aoff + m * 2048 + k * 1024); } while (0)
#define PG8_LDB(dst, b, h) do { _Pragma("unroll") for (int n = 0; n < 2; ++n) _Pragma("unroll") for (int k = 0; k < 2; ++k) dst[n][k] = *(const LAS bf16x8*)(lds + PG8_SB(b, h) + boff + n * 2048 + k * 1024); } while (0)
#define PG8_MMA(ai, bj, At, Bt) do { __builtin_amdgcn_s_setprio(1); _Pragma("unroll") for (int m = 0; m < 4; ++m) _Pragma("unroll") for (int n = 0; n < 2; ++n) _Pragma("unroll") for (int k = 0; k < 2; ++k) \
        acc[ai][bj][m][n] = __builtin_amdgcn_mfma_f32_16x16x32_bf16(Bt[n][k], At[m][k], acc[ai][bj][m][n], 0, 0, 0); __builtin_amdgcn_s_setprio(0); } while (0)
#define PG8_WAIT_V(n) asm volatile("s_waitcnt vmcnt(" #n ")" ::: "memory")
#define PG8_WAIT_L(n) asm volatile("s_waitcnt lgkmcnt(" #n ")" ::: "memory")
#define PG8_BAR __builtin_amdgcn_s_barrier()
#define PG8_SCHED __builtin_amdgcn_sched_barrier(0)
    Unit cur, nxt; int ui = 0;
    if (!S.next(0, cur)) return;
    f32x4 acc[2][2][4][2];
#pragma unroll
    for (int a = 0; a < 2; ++a)
#pragma unroll
        for (int b = 0; b < 2; ++b)
#pragma unroll
            for (int m = 0; m < 4; ++m)
#pragma unroll
                for (int n = 0; n < 2; ++n) acc[a][b][m][n] = (f32x4){0.f, 0.f, 0.f, 0.f};
    bf16x8 At[4][2], B0[2][2], B1[2][2];
    const char* cA = cur.a; const char* cB = cur.b;
    unsigned voffB[2]; PG8_VOFFB(voffB, cur.bstr);
    size_t hstepB = hstepA * (size_t)cur.bstr;
    PG8_STAGE(PG8_SB(0, 0), cB, voffB); PG8_STAGE(PG8_SB(0, 1), cB + hstepB, voffB); PG8_STAGE(PG8_SA(0, 0), cA, voffA); PG8_STAGE(PG8_SA(0, 1), cA + hstepA, voffA);
    if (wr == 1) PG8_BAR;
    PG8_WAIT_V(2); PG8_BAR;
    PG8_STAGE(PG8_SB(1, 0), cB + kstep, voffB); PG8_STAGE(PG8_SA(1, 0), cA + kstep, voffA); PG8_STAGE(PG8_SB(1, 1), cB + hstepB + kstep, voffB);
    PG8_WAIT_V(6); PG8_BAR;
    for (;;) {
        const bool has_next = S.next(ui + 1, nxt);
        const char* nA = has_next ? nxt.a : cA; const char* nB = has_next ? nxt.b : cB;
        const int nbstr = has_next ? nxt.bstr : cur.bstr;
        for (int t = 0; t < nt; t += 2) {
            const bool last = (t == nt - 2);
            const char* a1 = cA + (size_t)(t + 1) * kstep;
            const char* a2 = last ? nA : cA + (size_t)(t + 2) * kstep; const char* b2 = last ? nB : cB + (size_t)(t + 2) * kstep;
            const char* a3 = a2 + kstep; const char* b3 = b2 + kstep;
            if (last) { PG8_VOFFB(voffB, nbstr); hstepB = hstepA * (size_t)nbstr; }
            PG8_LDB(B0, 0, 0); PG8_LDB(B1, 0, 1); PG8_SCHED; PG8_LDA(At, 0, 0); PG8_STAGE(PG8_SA(1, 1), a1 + hstepA, voffA);
            PG8_WAIT_V(8); PG8_WAIT_L(0); PG8_BAR; PG8_MMA(0, 0, At, B0); PG8_MMA(0, 1, At, B1); PG8_BAR; PG8_SCHED;
            PG8_LDA(At, 0, 1); PG8_STAGE(PG8_SB(0, 0), b2, voffB); PG8_STAGE(PG8_SB(0, 1), b2 + hstepB, voffB); PG8_STAGE(PG8_SA(0, 0), a2, voffA);
            PG8_WAIT_V(8); PG8_WAIT_L(0); PG8_BAR; PG8_MMA(1, 0, At, B0); PG8_MMA(1, 1, At, B1); PG8_BAR; PG8_SCHED;
            PG8_LDB(B0, 1, 0); PG8_LDB(B1, 1, 1); PG8_SCHED; PG8_LDA(At, 1, 0); PG8_STAGE(PG8_SA(0, 1), a2 + hstepA, voffA);
            PG8_WAIT_V(8); PG8_WAIT_L(0); PG8_BAR; PG8_MMA(0, 0, At, B0); PG8_MMA(0, 1, At, B1); PG8_BAR; PG8_SCHED;
            PG8_LDA(At, 1, 1); PG8_STAGE(PG8_SB(1, 0), b3, voffB); PG8_STAGE(PG8_SB(1, 1), b3 + hstepB, voffB); PG8_STAGE(PG8_SA(1, 0), a3, voffA);
            PG8_WAIT_V(8); PG8_WAIT_L(0); PG8_BAR; PG8_MMA(1, 0, At, B0); PG8_MMA(1, 1, At, B1); PG8_BAR; PG8_SCHED;
        }
        if (wr == 0) PG8_BAR;
        E(acc, cur, wr, wc, fr, fq);
        if (!has_next) break;
#pragma unroll
        for (int a = 0; a < 2; ++a)
#pragma unroll
            for (int b = 0; b < 2; ++b)
#pragma unroll
                for (int m = 0; m < 4; ++m)
#pragma unroll
                    for (int n = 0; n < 2; ++n) acc[a][b][m][n] = (f32x4){0.f, 0.f, 0.f, 0.f};
        cur = nxt; cA = nA; cB = nB; ++ui;
        if (wr == 1) PG8_BAR;
    }
    PG8_WAIT_V(0);
    PG8_BAR;
#undef PG8_SA
#undef PG8_SB
#undef PG8_STAGE
#undef PG8_LDA
#undef PG8_LDB
#undef PG8_MMA
#undef PG8_WAIT_V
#undef PG8_WAIT_L
#undef PG8_BAR
#undef PG8_SCHED
#undef PG8_VOFFB
}

struct SchedPlain {
    const char* A; const char* Bt; int nN, K, G, c;
    __device__ __forceinline__ bool next(int i, Unit& u) const {
        const int L = i * G + c; if (L >= 64 * nN) return false;
        const int xcd = L & 7, idx = L >> 3;
        u.pm = 8 * xcd + (idx & 7); u.pn = idx >> 3; u.kind = 0; u.bstr = 1; u.brow = 0;
        u.a = A + (size_t)u.pm * 256 * K * 2; u.b = Bt + (size_t)u.pn * 256 * K * 2; return true;
    }
};
struct SchedProj {
    const char* XB; const char* WT; int layer, G, c;
    __device__ __forceinline__ bool next(int i, Unit& u) const {
        const int L = i * G + c; if (L >= 1280) return false;
        const int xcd = L & 7, idx = L >> 3;
        constexpr int K = DM;
        if (idx < 112) {
            u.pm = 8 * xcd + (idx & 7); u.pn = idx >> 3; u.kind = 0; u.bstr = 1; u.brow = 0;
            u.a = XB + (size_t)u.pm * 256 * K * 2; u.b = WT + (size_t)u.pn * 256 * K * 2;
        } else {
            const int j2 = idx - 112; u.pm = j2 >> 3; u.pn = 8 * xcd + (j2 & 7); u.kind = 1;
            const int g = u.pm >> 1; const int dl = (layer == 1) ? (g == 0 ? 1 : (g == 1 ? 4 : 16)) : 1;
            const int b = u.pn >> 4, j = u.pn & 15, tpc = 16 / dl, r = j / tpc, cc = j % tpc;
            u.bstr = dl; u.brow = b * SEQ + dl * 256 * cc + r;
            u.a = WT + (size_t)(QKW + 256 * u.pm) * K * 2; u.b = XB + (size_t)u.brow * K * 2;
        }
        return true;
    }
};

struct EpiProj {
    bf16_t* QK; bf16_t* VT; const u64* ssq; float qscale_mix, qscale_mem; int layer;
    __device__ __forceinline__ void operator()(const f32x4 (&acc)[2][2][4][2], const Unit& u, int wr, int wc, int fr, int fq) const {
        if (u.kind == 0) {
            const int row0 = u.pm * 256 + wr * 64 + fr, col0 = u.pn * 256 + wc * 32 + 8 * fq;
            const float cs = (u.pn < 6) ? qscale_mix : ((u.pn >= 12) ? qscale_mem : 1.0f);
            const bool kfrag = (layer == 1) && (u.pn >= 6) && (u.pn < 12);
            const int qkw = layer == 0 ? QKW : 2048, cofs = (layer == 1 && u.pn >= 12) ? 1536 : 0;
            bf16_t* KF = QK + 32 * MiB;
#pragma unroll
            for (int ai = 0; ai < 2; ++ai)
#pragma unroll
                for (int m = 0; m < 4; ++m) { const int row = row0 + ai * 128 + m * 16; const float rs = rstd_of(ssq[row]) * cs;
#pragma unroll
                    for (int bj = 0; bj < 2; ++bj) { const f32x4 v0 = acc[ai][bj][m][0] * rs, v1 = acc[ai][bj][m][1] * rs; u32x4 w;
                        w.x = cvt_pk_bf16(v0[0], v0[1]); w.y = cvt_pk_bf16(v0[2], v0[3]); w.z = cvt_pk_bf16(v1[0], v1[1]); w.w = cvt_pk_bf16(v1[2], v1[3]);
                        if (!kfrag) *(u32x4*)(QK + (size_t)row * qkw + col0 - cofs + bj * 128) = w;
                        else { const int h = (u.pn - 6) * 2 + bj, g = h >> 2, dl = g == 0 ? 1 : (g == 1 ? 4 : 16), sh = g == 0 ? 0 : (g == 1 ? 2 : 4);
                            const int b = row >> 12, tok = row & 4095, r = tok & (dl - 1), n = tok >> sh, rr = n & 31, ctile = r * (128 >> sh) + (n >> 5);
                            const int d0 = wc * 2 + (fq >> 1), hip = fq & 1, prw = (rr & 19) | ((rr & 4) << 1) | ((rr & 8) >> 1);
                            *(u32x4*)(KF + (size_t)(b * NH + h) * 524288 + (size_t)((ctile * 8 + d0) * 64 + hip * 32 + prw) * 8) = w; } } }
        } else {
            const int row0 = u.pm * 256 + wr * 64 + fr, cin0 = wc * 32 + 8 * fq;
            float rs[2][8];
#pragma unroll
            for (int bj = 0; bj < 2; ++bj)
#pragma unroll
                for (int e = 0; e < 8; ++e) rs[bj][e] = rstd_of(ssq[u.brow + (cin0 + bj * 128 + e) * u.bstr]);
#pragma unroll
            for (int ai = 0; ai < 2; ++ai)
#pragma unroll
                for (int m = 0; m < 4; ++m) { const int row = row0 + ai * 128 + m * 16;
#pragma unroll
                    for (int bj = 0; bj < 2; ++bj) { const f32x4 a0 = acc[ai][bj][m][0], a1 = acc[ai][bj][m][1]; u32x4 w;
                        w.x = cvt_pk_bf16(a0[0] * rs[bj][0], a0[1] * rs[bj][1]); w.y = cvt_pk_bf16(a0[2] * rs[bj][2], a0[3] * rs[bj][3]);
                        w.z = cvt_pk_bf16(a1[0] * rs[bj][4], a1[1] * rs[bj][5]); w.w = cvt_pk_bf16(a1[2] * rs[bj][6], a1[3] * rs[bj][7]);
                        if (layer == 0) *(u32x4*)(VT + (size_t)row * MTOK + u.pn * 256 + cin0 + bj * 128) = w;
                        else { const int h = row >> 7, dd = row & 127, db = dd >> 5, rr = dd & 31, b = u.pn >> 4, P = 256 * (u.pn & 15) + cin0 + bj * 128;
                            *(u32x4*)(VT + (size_t)(b * NH + h) * 524288 + (size_t)((((P >> 5) * 4 + db) * 2 + ((P >> 4) & 1)) * 64 + ((P >> 3) & 1) * 32 + rr) * 8) = w; } } }
        }
    }
};
struct EpiRelu2 {
    bf16_t* H; const u64* ssq;
    __device__ __forceinline__ void operator()(const f32x4 (&acc)[2][2][4][2], const Unit& u, int wr, int wc, int fr, int fq) const {
        const int row0 = u.pm * 256 + wr * 64 + fr, col0 = u.pn * 256 + wc * 32 + 8 * fq;
#pragma unroll
        for (int ai = 0; ai < 2; ++ai)
#pragma unroll
            for (int m = 0; m < 4; ++m) { const int row = row0 + ai * 128 + m * 16; const float rs = rstd_of(ssq[row]); bf16_t* rowp = H + (size_t)row * FF + col0;
#pragma unroll
                for (int bj = 0; bj < 2; ++bj) { f32x4 v0 = acc[ai][bj][m][0] * rs, v1 = acc[ai][bj][m][1] * rs;
#pragma unroll
                    for (int e = 0; e < 4; ++e) { const float a = fmaxf(v0[e], 0.f), b = fmaxf(v1[e], 0.f); v0[e] = a * a; v1[e] = b * b; }
                    u32x4 w; w.x = cvt_pk_bf16(v0[0], v0[1]); w.y = cvt_pk_bf16(v0[2], v0[3]); w.z = cvt_pk_bf16(v1[0], v1[1]); w.w = cvt_pk_bf16(v1[2], v1[3]);
                    *(u32x4*)(rowp + bj * 128) = w; } }
    }
};
struct EpiRes {
    bf16_t* xb; u64* ssq;
    __device__ __forceinline__ void operator()(const f32x4 (&acc)[2][2][4][2], const Unit& u, int wr, int wc, int fr, int fq) const {
        const int row0 = u.pm * 256 + wr * 64 + fr, col0 = u.pn * 256 + wc * 32 + 8 * fq;
#pragma unroll
        for (int ai = 0; ai < 2; ++ai)
#pragma unroll
            for (int m = 0; m < 4; ++m) { const int row = row0 + ai * 128 + m * 16; const size_t off = (size_t)row * DM + col0; float ss = 0.f;
#pragma unroll
                for (int bj = 0; bj < 2; ++bj) {
                    const u32x4 xo = *(const u32x4*)(xb + off + bj * 128);
                    const f32x4 v0 = (f32x4){bf_lo(xo.x), bf_hi(xo.x), bf_lo(xo.y), bf_hi(xo.y)} + acc[ai][bj][m][0], v1 = (f32x4){bf_lo(xo.z), bf_hi(xo.z), bf_lo(xo.w), bf_hi(xo.w)} + acc[ai][bj][m][1];
                    u32x4 w; w.x = cvt_pk_bf16(v0[0], v0[1]); w.y = cvt_pk_bf16(v0[2], v0[3]); w.z = cvt_pk_bf16(v1[0], v1[1]); w.w = cvt_pk_bf16(v1[2], v1[3]);
                    *(u32x4*)(xb + off + bj * 128) = w;
                    ss += (v0[0] * v0[0] + v0[1] * v0[1]) + (v0[2] * v0[2] + v0[3] * v0[3]) + (v1[0] * v1[0] + v1[1] * v1[1]) + (v1[2] * v1[2] + v1[3] * v1[3]); }
                ss += __shfl_xor(ss, 16); ss += __shfl_xor(ss, 32);
                if (fq == 0) atomicAdd((u64*)(ssq + row), (u64)(ss * SSQ_FIX));
                asm volatile("" ::: "memory"); }
    }
};
}

struct Params {
    const float *x, *mem, *g_attn, *w_in, *w_out, *lambda_qk, *subln_g, *g_mem, *w_mem_kv, *g_mlp, *w_mlp1, *w_mlp2, *g_final;
    float* out; unsigned char* ws;
};

constexpr int NWAVES = 8;
constexpr int LDS_BYTES = 147456;

__device__ __forceinline__ void transpose_item(const float* __restrict__ W, int K, int N, bf16_t* __restrict__ WT, const float* __restrict__ g, int permute_in, int item, int lane) {
    const int nblk = N / 64, kb = item / nblk, nb = item % nblk, k0 = 64 * kb, n0 = 64 * nb;
    const float* src = W + (size_t)k0 * N + n0 + lane;
    float v[64];
#pragma unroll
    for (int i = 0; i < 64; ++i) v[i] = src[(size_t)i * N];
    if (g) {
#pragma unroll
        for (int i = 0; i < 64; ++i) v[i] *= g[k0 + i];
    }
    int nr0 = n0;
    if (permute_in) { if (n0 >= 4608) nr0 = n0 - 1536; else if (n0 >= 3072) nr0 = n0 + 512; }
    u32x4* dst = (u32x4*)(WT + (size_t)(nr0 + lane) * K + k0);
#pragma unroll
    for (int c = 0; c < 8; ++c) { u32x4 o; o.x = cvt_pk_bf16(v[8 * c], v[8 * c + 1]); o.y = cvt_pk_bf16(v[8 * c + 2], v[8 * c + 3]); o.z = cvt_pk_bf16(v[8 * c + 4], v[8 * c + 5]); o.w = cvt_pk_bf16(v[8 * c + 6], v[8 * c + 7]); dst[c] = o; }
}
__device__ __forceinline__ void phase_weights(const Params& p, int layer, LAS unsigned char* lds, int gw, int NGW, int wave, int lane) {
    asm volatile("" : "+v"(lane));
    unsigned char* ws = p.ws + (size_t)layer * WS_WL1;
    constexpr int I_IN = (DM / 64) * (INW / 64), I_OUT = (DM / 64) * (DM / 64), I_1 = (DM / 64) * (FF / 64), I_2 = (FF / 64) * (DM / 64);
    constexpr int NITEMS = I_IN + I_OUT + I_1 + I_2;
    for (int it = gw; it < NITEMS; it += NGW) {
        int r = it;
        if (r < I_IN) { transpose_item(p.w_in + (size_t)layer * DM * INW, DM, INW, (bf16_t*)(ws + WS_WIN), p.g_attn + layer * DM, 1, r, lane); continue; } r -= I_IN;
        if (r < I_OUT) { transpose_item(p.w_out + (size_t)layer * DM * DM, DM, DM, (bf16_t*)(ws + WS_WOUT), nullptr, 0, r, lane); continue; } r -= I_OUT;
        if (r < I_1) { transpose_item(p.w_mlp1 + (size_t)layer * DM * FF, DM, FF, (bf16_t*)(ws + WS_W1), p.g_mlp + layer * DM, 0, r, lane); continue; } r -= I_1;
        transpose_item(p.w_mlp2 + (size_t)layer * FF * DM, FF, DM, (bf16_t*)(ws + WS_W2), nullptr, 0, r, lane);
    }
}
__device__ __forceinline__ void phase_xprep(const Params& p, int gw, int NGW, int lane) {
    asm volatile("" : "+v"(lane));
    bf16_t* XB = (bf16_t*)(p.ws + WS_XB); u64* ssq = (u64*)(p.ws + SSQ_OFF);
    for (int m = gw; m < MTOK; m += NGW) {
        const f32x4* xr = (const f32x4*)(p.x + (size_t)m * DM) + lane; f32x4 v[8]; float s = 0.f;
#pragma unroll
        for (int j = 0; j < 8; ++j) { v[j] = xr[64 * j]; s += (v[j].x * v[j].x + v[j].y * v[j].y) + (v[j].z * v[j].z + v[j].w * v[j].w); }
        s = wave_sum(s);
        if (lane == 0) ssq[m] = (u64)(s * SSQ_FIX);
        u32x2* o8 = (u32x2*)(XB + (size_t)m * DM) + lane;
#pragma unroll
        for (int j = 0; j < 8; ++j) { u32x2 w; w.x = cvt_pk_bf16(v[j].x, v[j].y); w.y = cvt_pk_bf16(v[j].z, v[j].w); o8[64 * j] = w; }
    }
}
__device__ __forceinline__ void phase_memkv(const Params& p, int gw, int NGW, int lane) {
    asm volatile("" : "+v"(lane));
    const int r32 = lane & 31, hi = lane >> 5;
    for (int it = gw; it < 2048; it += NGW) {
        const int layer = it >> 10, typ = (it >> 9) & 1, tt = it & 511;
        const int mt = typ == 0 ? (tt >> 4) : (tt & 31), nt = typ == 0 ? (tt & 15) : (tt >> 5);
        const float* mrow = p.mem + (size_t)(32 * mt + r32) * DM + 8 * hi;
        const float* wcol = p.w_mem_kv + (size_t)layer * DM * 1024 + (size_t)(8 * hi) * 1024 + typ * 512 + 32 * nt + r32;
        const float* gm = p.g_mem + 8 * hi;
        f32x16 acc = {}; float ss = 0.f;
#pragma unroll 8
        for (int k0 = 0; k0 < DM; k0 += 16) {
            const f32x4 a0 = *(const f32x4*)(mrow + k0), a1 = *(const f32x4*)(mrow + k0 + 4);
            const f32x4 g0 = *(const f32x4*)(gm + k0), g1 = *(const f32x4*)(gm + k0 + 4);
            float w[8];
#pragma unroll
            for (int j = 0; j < 8; ++j) w[j] = wcol[(size_t)(k0 + j) * 1024];
            ss += (a0.x * a0.x + a0.y * a0.y) + (a0.z * a0.z + a0.w * a0.w) + (a1.x * a1.x + a1.y * a1.y) + (a1.z * a1.z + a1.w * a1.w);
            u32x4 mf, wf;
            mf.x = cvt_pk_bf16(a0.x * g0.x, a0.y * g0.y); mf.y = cvt_pk_bf16(a0.z * g0.z, a0.w * g0.w); mf.z = cvt_pk_bf16(a1.x * g1.x, a1.y * g1.y); mf.w = cvt_pk_bf16(a1.z * g1.z, a1.w * g1.w);
            wf.x = cvt_pk_bf16(w[0], w[1]); wf.y = cvt_pk_bf16(w[2], w[3]); wf.z = cvt_pk_bf16(w[4], w[5]); wf.w = cvt_pk_bf16(w[6], w[7]);
            const bf16x8 mfr = __builtin_bit_cast(bf16x8, mf), wfr = __builtin_bit_cast(bf16x8, wf);
            if (typ == 0) acc = __builtin_amdgcn_mfma_f32_32x32x16_bf16(mfr, wfr, acc, 0, 0, 0);
            else          acc = __builtin_amdgcn_mfma_f32_32x32x16_bf16(wfr, mfr, acc, 0, 0, 0);
        }
        ss += swap32(ss);
        const float rs = rsqrtf(ss * (1.0f / DM) + EPS);
        bf16_t* KM = (bf16_t*)(p.ws + WS_KM + (size_t)layer * 2 * MiB); bf16_t* VMT = KM + 1024 * 512;
        if (typ == 0) {
            const int d = 32 * nt + r32, hm = d >> 7, dd = d & 127, d0 = dd >> 4, hip = (dd >> 3) & 1, j = dd & 7;
            const int b = mt >> 3, tile = mt & 7;
#pragma unroll
            for (int r = 0; r < 16; ++r) { const int row = (r & 3) + 8 * (r >> 2) + 4 * hi; const float rr = __shfl(rs, row);
                const int prw = (row & 19) | ((row & 4) << 1) | ((row & 8) >> 1);
                KM[((((size_t)(b * 4 + hm) * 8 + tile) * 8 + d0) * 64 + hip * 32 + prw) * 8 + j] = (bf16_t)(cvt_pk_bf16(acc[r] * rr, 0.f) & 0xffffu); }
        } else {
            const int b = mt >> 3, tile = mt & 7, s2 = (r32 >> 4) & 1, hip = (r32 >> 3) & 1, j = r32 & 7;
#pragma unroll
            for (int r = 0; r < 16; ++r) { const int row = (r & 3) + 8 * (r >> 2) + 4 * hi; const int v = 32 * nt + row, hm = v >> 7, dd = v & 127, db = dd >> 5, rr = dd & 31;
                VMT[(((((size_t)(b * 4 + hm) * 8 + tile) * 4 + db) * 2 + s2) * 64 + hip * 32 + rr) * 8 + j] = (bf16_t)(cvt_pk_bf16(acc[r] * rs, 0.f) & 0xffffu); }
        }
    }
}
__device__ __forceinline__ void phase_final(const Params& p, int gw, int NGW, int lane) {
    asm volatile("" : "+v"(lane));
    const u64* ssq = (const u64*)(p.ws + SSQ_OFF) + 4 * MTOK; const bf16_t* XB = (const bf16_t*)(p.ws + WS_XB);
    for (int m = gw; m < MTOK; m += NGW) {
        const u32x4* xr = (const u32x4*)(XB + (size_t)m * DM) + lane; f32x4* orow = (f32x4*)(p.out + (size_t)m * DM) + 2 * lane; const f32x4* gr = (const f32x4*)p.g_final + 2 * lane; const float rs = rstd_of(ssq[m]);
#pragma unroll
        for (int j = 0; j < 4; ++j) { const u32x4 v = xr[64 * j]; const f32x4 g0 = gr[128 * j], g1 = gr[128 * j + 1];
            orow[128 * j] = (f32x4){bf_lo(v.x), bf_hi(v.x), bf_lo(v.y), bf_hi(v.y)} * g0 * rs; orow[128 * j + 1] = (f32x4){bf_lo(v.z), bf_hi(v.z), bf_lo(v.w), bf_hi(v.w)} * g1 * rs; }
    }
}

__device__ __forceinline__ float alibi_slope(int h) { return h < 8 ? exp2f(-0.5f * (float)(h + 1)) : exp2f(-(float)(h - 3)); }
__device__ __forceinline__ float xhalf_max(float v) { auto rr = __builtin_amdgcn_permlane32_swap(__float_as_uint(v), __float_as_uint(v), false, false); return fmaxf(__uint_as_float(rr[0]), __uint_as_float(rr[1])); }
__device__ __forceinline__ float xhalf_sum(float v) { auto rr = __builtin_amdgcn_permlane32_swap(__float_as_uint(v), __float_as_uint(v), false, false); return __uint_as_float(rr[0]) + __uint_as_float(rr[1]); }

template <bool BIAS>
__device__ __forceinline__ void attn_core(f32x16 (&o)[4], float& m_run, float& l_run, const bf16_t* __restrict__ qrow, const bf16_t* __restrict__ ktile0, const bf16_t* __restrict__ vtile0,
                                          int t_hi, int t_lo, int qt, int iq, float slope2, int W, int lane, int hi) {
    bf16x8 qf[8], kf[8];
#pragma unroll
    for (int d0 = 0; d0 < 8; ++d0) qf[d0] = *(const bf16x8*)(qrow + 16 * d0 + 8 * hi);
    const bf16_t* kp = ktile0 + (long)t_hi * 4096 + lane * 8;
    const bf16_t* vp = vtile0 + (long)t_hi * 4096 + lane * 8;
#pragma unroll
    for (int d0 = 0; d0 < 8; ++d0) kf[d0] = *(const bf16x8*)(kp + d0 * 512);
    for (int t = t_hi; t >= t_lo; --t) {
        bf16x8 vf[4][2];
#pragma unroll
        for (int db = 0; db < 4; ++db)
#pragma unroll
            for (int s2 = 0; s2 < 2; ++s2) vf[db][s2] = *(const bf16x8*)(vp + (db * 2 + s2) * 512);
        f32x16 sc = {};
#pragma unroll
        for (int d0 = 0; d0 < 8; ++d0) sc = __builtin_amdgcn_mfma_f32_32x32x16_bf16(kf[d0], qf[d0], sc, 0, 0, 0);
        if (t > t_lo) { kp -= 4096;
#pragma unroll
            for (int d0 = 0; d0 < 8; ++d0) kf[d0] = *(const bf16x8*)(kp + d0 * 512); }
        vp -= 4096;
        float tb = 0.f;
        if (BIAS) {
            const int base = iq - 32 * t - 8 * hi;
            tb = -slope2 * (float)base;
#pragma unroll
            for (int r = 0; r < 16; ++r) sc[r] = fmaf(slope2, (float)(16 * (r >> 3) + (r & 7)), sc[r]);
            if ((t == qt) || (32 * (qt - t) + 31 > W)) {
#pragma unroll
                for (int r = 0; r < 16; ++r) { const int d = base - (16 * (r >> 3) + (r & 7)); if (d < 0 || d > W) sc[r] = -INFINITY; }
            }
        }
        float mx = fmaxf(sc[0], sc[1]);
#pragma unroll
        for (int r = 2; r < 16; ++r) mx = fmaxf(mx, sc[r]);
        const float mt = xhalf_max(mx + tb);
        if (__any(mt > m_run + 8.0f)) {
            const float mn = fmaxf(m_run, mt), f = __builtin_amdgcn_exp2f(m_run - mn);
            l_run *= f;
#pragma unroll
            for (int db = 0; db < 4; ++db)
#pragma unroll
                for (int r = 0; r < 16; ++r) o[db][r] *= f;
            m_run = mn;
        }
        const float ml = m_run - tb; float ps = 0.f;
#pragma unroll
        for (int r = 0; r < 16; ++r) { sc[r] = __builtin_amdgcn_exp2f(sc[r] - ml); ps += sc[r]; }
        l_run += ps;
        u32x4 p0, p1;
        p0.x = cvt_pk_bf16(sc[0], sc[1]); p0.y = cvt_pk_bf16(sc[2], sc[3]); p0.z = cvt_pk_bf16(sc[4], sc[5]); p0.w = cvt_pk_bf16(sc[6], sc[7]);
        p1.x = cvt_pk_bf16(sc[8], sc[9]); p1.y = cvt_pk_bf16(sc[10], sc[11]); p1.z = cvt_pk_bf16(sc[12], sc[13]); p1.w = cvt_pk_bf16(sc[14], sc[15]);
        const bf16x8 pf0 = __builtin_bit_cast(bf16x8, p0), pf1 = __builtin_bit_cast(bf16x8, p1);
#pragma unroll
        for (int db = 0; db < 4; ++db) { o[db] = __builtin_amdgcn_mfma_f32_32x32x16_bf16(vf[db][0], pf0, o[db], 0, 0, 0); o[db] = __builtin_amdgcn_mfma_f32_32x32x16_bf16(vf[db][1], pf1, o[db], 0, 0, 0); }
    }
}
__device__ __forceinline__ void store_o(bf16_t* dst, const f32x16 (&o)[4], float scale, int hi) {
#pragma unroll
    for (int db = 0; db < 4; ++db)
#pragma unroll
        for (int g4 = 0; g4 < 4; ++g4) { u32x2 w; w.x = cvt_pk_bf16(o[db][4 * g4] * scale, o[db][4 * g4 + 1] * scale); w.y = cvt_pk_bf16(o[db][4 * g4 + 2] * scale, o[db][4 * g4 + 3] * scale);
            *(u32x2*)(dst + 32 * db + 8 * g4 + 4 * hi) = w; }
}
__device__ __forceinline__ void attn_mem_unit(const Params& p, int layer, int pair, int qt, int lane, int r32, int hi) {
    const bf16_t* QK = (const bf16_t*)(p.ws + WS_QK); const bf16_t* KMF = (const bf16_t*)(p.ws + WS_KM + (size_t)layer * 2 * MiB); const bf16_t* VMF = KMF + 1024 * 512; bf16_t* MRG = (bf16_t*)(p.ws + WS_MRG);
    const int b = pair >> 2, hm = pair & 3; const long token = (long)b * SEQ + 32 * qt + r32;
    const int qkw = layer == 0 ? QKW : 2048, qmo = layer == 0 ? 3072 : 1536;
    f32x16 o[4] = {}; float m = -INFINITY, l = 0.f;
    attn_core<false>(o, m, l, QK + token * qkw + qmo + hm * 128, KMF + (long)pair * 32768, VMF + (long)pair * 32768, 7, 0, 0, 0, 0.f, 0, lane, hi);
    const float inv = 1.0f / xhalf_sum(l);
    store_o(MRG + token * DM + MIXW + hm * 128, o, inv, hi);
}
constexpr int DA_KPITCH = 144, DA_VOFF = 64 * DA_KPITCH, DA_BUF = DA_VOFF + 128 * DA_KPITCH, DA_STASH = 57344, DA_WORD = DA_STASH + 8 * 8192;
__device__ __forceinline__ void diff_block_unit(const Params& p, int bh, int qb, float lam, LAS unsigned char* lds, int& cur, int tid, int wave, int lane, int r32, int hi) {
    const bf16_t* QK = (const bf16_t*)(p.ws + WS_QK); const bf16_t* VT = (const bf16_t*)(p.ws + WS_VT); bf16_t* MRG = (bf16_t*)(p.ws + WS_MRG);
    const int b = bh / NH, h = bh % NH; const int Q0 = 256 * qb + 32 * wave, iq = Q0 + r32; const long token = (long)b * SEQ + iq;
    const float slope2 = alibi_slope(h) * LOG2E;
    LAS unsigned* stash = (LAS unsigned*)(lds + DA_STASH + wave * 8192);
    const int krow = tid >> 3, kch = tid & 7, vrow = tid >> 2, vq4 = tid & 3;
    const bf16_t* kg = QK + ((long)b * SEQ + krow) * QKW + MIXW + h * 128 + 8 * kch;
    const bf16_t* vg = VT + (long)(h * 128 + vrow) * MTOK + (long)b * SEQ + 16 * vq4;
    const int kdst = krow * DA_KPITCH + kch * 16, vdst = DA_VOFF + vrow * DA_KPITCH + vq4 * 32;
    const int prow = (r32 & 19) | ((r32 & 4) << 1) | ((r32 & 8) >> 1);
    const int kread = prow * DA_KPITCH + 16 * hi, vread = DA_VOFF + r32 * DA_KPITCH + 16 * hi;
    const int NT = 4 * qb + 4;
    f32x16 o[4], biasv;
#pragma unroll
    for (int r = 0; r < 16; ++r) biasv[r] = slope2 * (float)(8 * hi + 16 * (r >> 3) + (r & 7));
#pragma unroll 1
    for (int mi = 0; mi < 2; ++mi) {
        const int map = 1 - mi;
        bf16x8 qf[4];
#pragma unroll
        for (int d0 = 0; d0 < 4; ++d0) qf[d0] = *(const bf16x8*)(QK + token * QKW + h * 128 + 64 * map + 16 * d0 + 8 * hi);
#pragma unroll
        for (int db = 0; db < 4; ++db) o[db] = (f32x16){};
        float m_run = -INFINITY, l_run = 0.f;
        const bf16_t* kgp = kg + 64 * map + (long)(NT - 1) * 64 * QKW; const bf16_t* vgp = vg + 64 * (NT - 1);
        u32x4 kA = *(const u32x4*)kgp, vA0 = *(const u32x4*)vgp, vA1 = *(const u32x4*)(vgp + 8);
        u32x4 kB = *(const u32x4*)(kgp - 64 * QKW), vB0 = *(const u32x4*)(vgp - 64), vB1 = *(const u32x4*)(vgp - 64 + 8);
        kgp -= 128 * QKW; vgp -= 128;
        for (int tp = NT - 1; tp >= 1; tp -= 2) {
#pragma unroll
            for (int half = 0; half < 2; ++half) {
                const int t = tp - half;
                LAS unsigned char* bufp = lds + cur * DA_BUF;
                if (half == 0) { *(LAS u32x4*)(bufp + kdst) = kA; *(LAS u32x4*)(bufp + vdst) = vA0; *(LAS u32x4*)(bufp + vdst + 16) = vA1; }
                else           { *(LAS u32x4*)(bufp + kdst) = kB; *(LAS u32x4*)(bufp + vdst) = vB0; *(LAS u32x4*)(bufp + vdst + 16) = vB1; }
                __syncthreads();
                if (half == 0) { kA = *(const u32x4*)kgp; vA0 = *(const u32x4*)vgp; vA1 = *(const u32x4*)(vgp + 8); }
                else           { kB = *(const u32x4*)kgp; vB0 = *(const u32x4*)vgp; vB1 = *(const u32x4*)(vgp + 8); }
                if (t >= 3) { kgp -= 64 * QKW; vgp -= 64; }
#pragma unroll
                for (int s32 = 1; s32 >= 0; --s32) {
                    const int n0 = 64 * t + 32 * s32;
                    if (n0 <= Q0) {
                        bf16x8 kf[4];
    #pragma unroll
                        for (int d0 = 0; d0 < 4; ++d0) kf[d0] = *(const LAS bf16x8*)(bufp + kread + 32 * s32 * DA_KPITCH + 32 * d0);
                        f32x16 sc = __builtin_amdgcn_mfma_f32_32x32x16_bf16(kf[0], qf[0], biasv, 0, 0, 0);
    #pragma unroll
                        for (int d0 = 1; d0 < 4; ++d0) sc = __builtin_amdgcn_mfma_f32_32x32x16_bf16(kf[d0], qf[d0], sc, 0, 0, 0);
                        const int base = iq - n0 - 8 * hi;
                        const float tb = slope2 * (float)(n0 - 256 * qb - 256);
                        if (n0 == Q0) {
    #pragma unroll
                            for (int r = 0; r < 16; ++r) { if (base - (16 * (r >> 3) + (r & 7)) < 0) sc[r] = -INFINITY; }
                        }
                        float mx = fmaxf(sc[0], sc[1]);
    #pragma unroll
                        for (int r = 2; r < 16; ++r) mx = fmaxf(mx, sc[r]);
                        const float mt = xhalf_max(mx + tb);
                        if (__any(mt > m_run + 8.0f)) {
                            const float mn = fmaxf(m_run, mt), f = __builtin_amdgcn_exp2f(m_run - mn);
                            l_run *= f;
    #pragma unroll
                            for (int db = 0; db < 4; ++db)
    #pragma unroll
                                for (int r = 0; r < 16; ++r) o[db][r] *= f;
                            m_run = mn;
                        }
                        const float ml = m_run - tb; float ps = 0.f;
    #pragma unroll
                        for (int r = 0; r < 16; ++r) { sc[r] = __builtin_amdgcn_exp2f(sc[r] - ml); ps += sc[r]; }
                        l_run += ps;
                        u32x4 p0, p1;
                        p0.x = cvt_pk_bf16(sc[0], sc[1]); p0.y = cvt_pk_bf16(sc[2], sc[3]); p0.z = cvt_pk_bf16(sc[4], sc[5]); p0.w = cvt_pk_bf16(sc[6], sc[7]);
                        p1.x = cvt_pk_bf16(sc[8], sc[9]); p1.y = cvt_pk_bf16(sc[10], sc[11]); p1.z = cvt_pk_bf16(sc[12], sc[13]); p1.w = cvt_pk_bf16(sc[14], sc[15]);
                        const bf16x8 pf0 = __builtin_bit_cast(bf16x8, p0), pf1 = __builtin_bit_cast(bf16x8, p1);
    #pragma unroll
                        for (int db = 0; db < 4; ++db) {
                            const bf16x8 v0 = *(const LAS bf16x8*)(bufp + vread + 32 * db * DA_KPITCH + 64 * s32), v1 = *(const LAS bf16x8*)(bufp + vread + 32 * db * DA_KPITCH + 64 * s32 + 32);
                            o[db] = __builtin_amdgcn_mfma_f32_32x32x16_bf16(v0, pf0, o[db], 0, 0, 0); o[db] = __builtin_amdgcn_mfma_f32_32x32x16_bf16(v1, pf1, o[db], 0, 0, 0);
                        }
                    }
                }

                cur ^= 1;
            }
        }
        const float inv = 1.0f / xhalf_sum(l_run);
        if (mi == 0) {
            const float li = lam * inv;
#pragma unroll
            for (int db = 0; db < 4; ++db)
#pragma unroll
                for (int j = 0; j < 8; ++j) stash[(db * 8 + j) * 64 + lane] = cvt_pk_bf16(o[db][2 * j] * li, o[db][2 * j + 1] * li);
        } else {
#pragma unroll
            for (int db = 0; db < 4; ++db)
#pragma unroll
                for (int j = 0; j < 8; ++j) { const unsigned w = stash[(db * 8 + j) * 64 + lane]; o[db][2 * j] = o[db][2 * j] * inv - bf_lo(w); o[db][2 * j + 1] = o[db][2 * j + 1] * inv - bf_hi(w); }
        }
    }
    float ss = 0.f;
#pragma unroll
    for (int db = 0; db < 4; ++db)
#pragma unroll
        for (int r = 0; r < 16; ++r) ss += o[db][r] * o[db][r];
    ss = xhalf_sum(ss);
    const float rs = rsqrtf(ss * (1.0f / HD) + EPS) * 0.8f;
    bf16_t* dst = MRG + token * DM + h * 128;
#pragma unroll
    for (int db = 0; db < 4; ++db)
#pragma unroll
        for (int g4 = 0; g4 < 4; ++g4) { const f32x4 g = *(const f32x4*)(p.subln_g + 32 * db + 8 * g4 + 4 * hi); u32x2 w;
            w.x = cvt_pk_bf16(o[db][4 * g4] * rs * g.x, o[db][4 * g4 + 1] * rs * g.y); w.y = cvt_pk_bf16(o[db][4 * g4 + 2] * rs * g.z, o[db][4 * g4 + 3] * rs * g.w);
            *(u32x2*)(dst + 32 * db + 8 * g4 + 4 * hi) = w; }
}
__device__ __forceinline__ void attn_dil_unit(const Params& p, int bh, int u, int lane, int r32, int hi) {
    const bf16_t* QK = (const bf16_t*)(p.ws + WS_QK); const bf16_t* KF = (const bf16_t*)(p.ws + WS_QK + 64 * MiB); const bf16_t* VF = (const bf16_t*)(p.ws + WS_VT); bf16_t* MRG = (bf16_t*)(p.ws + WS_MRG); float* LSE = (float*)(p.ws + WS_LSE);
    const int b = bh / NH, h = bh % NH, g = h >> 2, dl = g == 0 ? 1 : (g == 1 ? 4 : 16), nqb = 128 / dl;
    const int r = u / nqb, qi = u % nqb, iq = 32 * qi + r32, tok = dl * iq + r; const long token = (long)b * SEQ + tok;
    const long toff = (long)bh * 524288 + (long)(r * nqb) * 4096;
    f32x16 o[4] = {}; float m = -INFINITY, l = 0.f;
    attn_core<true>(o, m, l, QK + token * 2048 + h * 128, KF + toff, VF + toff, qi, qi >= 4 ? qi - 4 : 0, qi, iq, alibi_slope(h) * (float)dl * LOG2E, 128, lane, hi);
    const float lt = xhalf_sum(l), inv = 1.0f / lt;
    store_o(MRG + token * DM + h * 128, o, inv, hi);
    if (hi == 0) LSE[(long)(b * NH + h) * SEQ + tok] = m + __builtin_amdgcn_logf(lt);
}
__device__ __forceinline__ void phase_attn(const Params& p, int layer, LAS unsigned char* lds, int tid, int wave, int lane) {
    asm volatile("" : "+v"(lane)); asm volatile("" : "+v"(tid));
    const int r32 = lane & 31, hi = lane >> 5;
    unsigned* ctl = (unsigned*)(p.ws + WS_CTL);
    const int x0 = blockIdx.x & 7;
    if (layer == 0) {
        const float a = p.lambda_qk[lane] * p.lambda_qk[64 + lane], b2 = p.lambda_qk[128 + lane] * p.lambda_qk[192 + lane];
        const float lam = expf(wave_sum(a)) - expf(wave_sum(b2)) + 0.2f;
        volatile LAS unsigned* word = (volatile LAS unsigned*)(lds + DA_WORD);
        int cur = 0;
        for (int xs = 0; xs < 8; ++xs) {
            const int x = (x0 + xs) & 7;
            for (;;) {
                __syncthreads();
                if (tid == 0) word[0] = atomicAdd(ctl + 64 * x, 1u);
                __syncthreads();
                const unsigned idx = (unsigned)__builtin_amdgcn_readfirstlane((int)word[0]);
                if (idx >= 96u) break;
                const int grp = idx >> 5, w = idx & 31;
                diff_block_unit(p, 6 * x + 2 * grp + (w & 1), 15 - (w >> 1), lam, lds, cur, tid, wave, lane, r32, hi);
            }
        }
    }
    unsigned* ctr = ctl + (layer == 0 ? 512 : 1024);
    const unsigned nper = layer == 0 ? 256u : 1024u;
    for (int xs = 0; xs < 8; ++xs) {
        const int x = (x0 + xs) & 7;
        for (;;) {
            unsigned idx = 0; if (lane == 0) idx = atomicAdd(ctr + 64 * x, 1u);
            idx = (unsigned)__builtin_amdgcn_readfirstlane((int)idx);
            if (idx >= nper) break;
            if (idx < 256u) attn_mem_unit(p, layer, 2 * x + (idx & 1), idx >> 1, lane, r32, hi);
            else { const int id = idx - 256; attn_dil_unit(p, 6 * x + (id >> 7), id & 127, lane, r32, hi); }
        }
    }
}
__device__ __forceinline__ void phase_fixup(const Params& p, int gw, int NGW, int lane) {
    asm volatile("" : "+v"(lane));
    bf16_t* MRG = (bf16_t*)(p.ws + WS_MRG); const float* LSE = (const float*)(p.ws + WS_LSE);
    for (int token = gw; token < MTOK; token += NGW) {
        const int b = token >> 12, t = token & 4095;
#pragma unroll
        for (int j = 0; j < 3; ++j) {
            const int c = lane + 64 * j, head = c >> 4, g = head >> 2, slot = head & 3;
            const float* lp = LSE + (long)(b * NH + slot) * SEQ + t;
            const float l0 = lp[0], l1 = lp[4 * SEQ], l2 = lp[8 * SEQ], mx = fmaxf(l0, fmaxf(l1, l2));
            const float e0 = __builtin_amdgcn_exp2f(l0 - mx), e1 = __builtin_amdgcn_exp2f(l1 - mx), e2 = __builtin_amdgcn_exp2f(l2 - mx);
            const float al = (g == 0 ? e0 : (g == 1 ? e1 : e2)) / (e0 + e1 + e2);
            u32x4* ptr = (u32x4*)(MRG + (size_t)token * DM + 8 * c); u32x4 v = *ptr;
            v.x = cvt_pk_bf16(bf_lo(v.x) * al, bf_hi(v.x) * al); v.y = cvt_pk_bf16(bf_lo(v.y) * al, bf_hi(v.y) * al);
            v.z = cvt_pk_bf16(bf_lo(v.z) * al, bf_hi(v.z) * al); v.w = cvt_pk_bf16(bf_lo(v.w) * al, bf_hi(v.w) * al);
            *ptr = v;
        }
    }
}


#define XB_TMO      128
#define XB_XCNT(j)  (256  + 64 * (j))
#define XB_XSUB(j)  (1280 + 64 * (j))
#define XB_XGEN(j)  (2304 + 64 * (j))
#define XB_TOP      3328
#define XB_TOPGEN   3392
#define XCD_BAR_WORDS 3456
#define XB_SPIN_CAP (1u << 18)
__device__ __forceinline__ unsigned xb_ld(unsigned* p)              { return __hip_atomic_load(p, __ATOMIC_RELAXED, __HIP_MEMORY_SCOPE_AGENT); }
__device__ __forceinline__ unsigned xb_add(unsigned* p, unsigned v) { return __hip_atomic_fetch_add(p, v, __ATOMIC_RELAXED, __HIP_MEMORY_SCOPE_AGENT); }
__device__ __forceinline__ unsigned xb_xcc_id() { return (unsigned)__builtin_amdgcn_s_getreg((3 << 11) | 20) & 0xFu; }
#define XB_SPIN(cond, bar) do { unsigned _sp = 0; while (cond) { __builtin_amdgcn_s_sleep(1); \
    if ((++_sp & 255u) == 0u) { if (xb_ld(&(bar)[XB_TMO])) break; if (_sp > XB_SPIN_CAP) { atomicAdd(&(bar)[XB_TMO], 1u); break; } } } } while (0)
struct XcdBarrier { unsigned* bar; unsigned x; volatile LAS unsigned* st; };
__device__ __forceinline__ XcdBarrier xcd_barrier_post(unsigned* bar, volatile LAS unsigned* st) {
    XcdBarrier b; b.bar = bar; b.x = xb_xcc_id(); b.st = st;
    if (threadIdx.x == 0) (void)xb_add(&bar[XB_XCNT(b.x)], 1u);
    return b;
}
__device__ __forceinline__ void xcd_barrier_complete(unsigned* bar, unsigned x, unsigned& nloc, unsigned& nx) {
    const unsigned G = gridDim.x * gridDim.y * gridDim.z;
    unsigned sum, cnt, mine, sp = 0u;
    for (;;) {
        sum = 0u; cnt = 0u; mine = 0u;
#pragma unroll
        for (unsigned j = 0; j < 16; ++j) { const unsigned c = xb_ld(&bar[XB_XCNT(j)]); sum += c; cnt += (c > 0u) ? 1u : 0u; mine = (j == x) ? c : mine; }
        if (sum == G) break;
        __builtin_amdgcn_s_sleep(1);
        if ((++sp & 255u) == 0u) { if (xb_ld(&bar[XB_TMO])) break; if (sp > XB_SPIN_CAP) { atomicAdd(&bar[XB_TMO], 1u); break; } }
    }
    nloc = mine > 0u ? mine : 1u; nx = cnt > 0u ? cnt : 1u;
}
__device__ __forceinline__ void xcd_barrier(const XcdBarrier& b) {
    asm volatile("s_waitcnt vmcnt(0)" ::: "memory");
    __syncthreads();
    if (threadIdx.x == 0) {
        unsigned* bar = b.bar;
        __builtin_amdgcn_s_waitcnt(0);
        unsigned nloc = b.st[0], nx = b.st[1];
        if (nloc == 0u) { xcd_barrier_complete(bar, b.x, nloc, nx); b.st[0] = nloc; b.st[1] = nx; }
        const unsigned old = xb_add(&bar[XB_XSUB(b.x)], 1u);
        const unsigned gen = old / nloc;
        if (old + 1u == (gen + 1u) * nloc) {
            __builtin_amdgcn_fence(__ATOMIC_RELEASE, "agent");
            asm volatile("s_waitcnt vmcnt(0)" ::: "memory");
            const unsigned og = xb_add(&bar[XB_TOP], 1u);
            const unsigned tg = og / nx;
            if (og + 1u == (tg + 1u) * nx) xb_add(&bar[XB_TOPGEN], 1u);
            else XB_SPIN(xb_ld(&bar[XB_TOPGEN]) == tg, bar);
            __builtin_amdgcn_fence(__ATOMIC_ACQUIRE, "agent");
            xb_add(&bar[XB_XGEN(b.x)], 1u);
            asm volatile("s_waitcnt vmcnt(0)" ::: "memory");
        } else {
            XB_SPIN(xb_ld(&bar[XB_XGEN(b.x)]) == gen, bar);
            __builtin_amdgcn_fence(__ATOMIC_ACQUIRE, "agent");
            asm volatile("s_waitcnt vmcnt(0)" ::: "memory");
        }
    }
    __syncthreads();
}

__global__ void __launch_bounds__(NWAVES * 64) mega_fwd(Params p) {
    extern __shared__ __attribute__((aligned(16))) unsigned char lds_raw[];
    LAS unsigned char* lds = (LAS unsigned char*)lds_raw;
    cg::grid_group grid = cg::this_grid();
    const int tid = threadIdx.x, lane = tid & 63, wave = __builtin_amdgcn_readfirstlane(tid >> 6);
    const int G = gridDim.x, c = blockIdx.x;
    const int gw = c * NWAVES + wave, NGW = G * NWAVES;
    unsigned char* ws = p.ws;
    u64* ssq = (u64*)(ws + SSQ_OFF);
    bf16_t* XB = (bf16_t*)(ws + WS_XB);

    volatile LAS unsigned* bst = (volatile LAS unsigned*)(lds + LDS_BYTES - 64);
    if (tid < 16) bst[tid] = 0u;
    __syncthreads();
    const XcdBarrier xbar = xcd_barrier_post((unsigned*)(ws + WS_CTL) + 4096, bst);
#define GRID_BAR() xcd_barrier(xbar)
    for (int st = 0; st < 3; ++st) {
        const int k = (wave & 1) ? st : 2 - st;
        if (k == 0) phase_memkv(p, gw, NGW, lane);
        else if (k == 1) phase_weights(p, 0, lds, gw, NGW, wave, lane);
        else phase_xprep(p, gw, NGW, lane);
    }
    grid.sync();

    for (int layer = 0; layer < 2; ++layer) {
        asm volatile("" : "+s"(ws));
        ssq = (u64*)(ws + SSQ_OFF); XB = (bf16_t*)(ws + WS_XB);
        {
            pg8::SchedProj S{(const char*)XB, (const char*)(ws + WS_WIN + (size_t)layer * WS_WL1), layer, G, c};
            pg8::EpiProj E{(bf16_t*)(ws + WS_QK), (bf16_t*)(ws + WS_VT), ssq + (size_t)(2 * layer) * MTOK,
                           (layer == 0 ? 0.125f : 0.08838834764831845f) * LOG2E, 0.08838834764831845f * LOG2E, layer};
            pg8::gemm_phase(lds, DM, S, E);
        }
        GRID_BAR();
        phase_attn(p, layer, lds, tid, wave, lane);
        if (layer == 0) phase_weights(p, 1, lds, gw, NGW, wave, lane);
        GRID_BAR();
        if (layer == 1) { phase_fixup(p, gw, NGW, lane); GRID_BAR(); }
        {
            pg8::SchedPlain S{(const char*)(ws + WS_MRG), (const char*)(ws + WS_WOUT + (size_t)layer * WS_WL1), DM / 256, DM, G, c};
            pg8::EpiRes E{XB, ssq + (size_t)(2 * layer + 1) * MTOK};
            pg8::gemm_phase(lds, DM, S, E);
        }
        GRID_BAR();
        {
            pg8::SchedPlain S{(const char*)XB, (const char*)(ws + WS_W1 + (size_t)layer * WS_WL1), FF / 256, DM, G, c};
            pg8::EpiRelu2 E{(bf16_t*)(ws + WS_BIG), ssq + (size_t)(2 * layer + 1) * MTOK};
            pg8::gemm_phase(lds, DM, S, E);
        }
        GRID_BAR();
        {
            pg8::SchedPlain S{(const char*)(ws + WS_BIG), (const char*)(ws + WS_W2 + (size_t)layer * WS_WL1), DM / 256, FF, G, c};
            pg8::EpiRes E{XB, ssq + (size_t)(2 * layer + 2) * MTOK};
            pg8::gemm_phase(lds, FF, S, E);
        }
        GRID_BAR();
    }
    phase_final(p, gw, NGW, lane);
}

extern "C" void kernel_launch(void* const* d_in, const int* in_sizes, int n_in, void* d_out, int out_size, void* d_ws, size_t ws_size, hipStream_t stream) {
    static int grid = 0;
    if (grid == 0) {
        if (n_in != 13 || ws_size < WS_END) { fprintf(stderr, "kernel_launch: unexpected inputs (n_in %d, ws %zu)\n", n_in, ws_size); grid = -1; return; }
        int dev = 0, cus = 0, per_cu = 0;
        hipGetDevice(&dev); hipDeviceGetAttribute(&cus, hipDeviceAttributeMultiprocessorCount, dev);
        hipFuncSetAttribute((const void*)mega_fwd, hipFuncAttributeMaxDynamicSharedMemorySize, LDS_BYTES);
        hipOccupancyMaxActiveBlocksPerMultiprocessor(&per_cu, (const void*)mega_fwd, NWAVES * 64, LDS_BYTES);
        if (per_cu < 1) per_cu = 1;
        (void)hipGetLastError();
        grid = cus * per_cu;
    }
    if (grid < 0) return;
    hipMemsetAsync((char*)d_ws + WS_CTL, 0, CTL_BYTES, stream);
    Params p{};
    p.x = (const float*)d_in[0]; p.mem = (const float*)d_in[1]; p.g_attn = (const float*)d_in[2]; p.w_in = (const float*)d_in[3]; p.w_out = (const float*)d_in[4];
    p.lambda_qk = (const float*)d_in[5]; p.subln_g = (const float*)d_in[6]; p.g_mem = (const float*)d_in[7]; p.w_mem_kv = (const float*)d_in[8];
    p.g_mlp = (const float*)d_in[9]; p.w_mlp1 = (const float*)d_in[10]; p.w_mlp2 = (const float*)d_in[11]; p.g_final = (const float*)d_in[12];
    p.out = (float*)d_out; p.ws = (unsigned char*)d_ws;
    void* args[] = {&p};
    hipError_t e = hipLaunchCooperativeKernel((const void*)mega_fwd, dim3(grid), dim3(NWAVES * 64), args, LDS_BYTES, stream);
    if (e != hipSuccess) fprintf(stderr, "cooperative launch failed: %s (grid %d)\n", hipGetErrorString(e), grid);
}
```

```cpp
#include <hip/hip_runtime.h>
#include <hip/hip_cooperative_groups.h>
#include <cstdio>
#include <cstdint>
namespace cg = cooperative_groups;

#define LAS __attribute__((address_space(3)))
typedef unsigned short bf16_t;
typedef short bf16x8 __attribute__((ext_vector_type(8)));
typedef float f32x4 __attribute__((ext_vector_type(4)));
typedef float f32x16 __attribute__((ext_vector_type(16)));
typedef unsigned u32x4 __attribute__((ext_vector_type(4)));
typedef unsigned u32x2 __attribute__((ext_vector_type(2)));
typedef unsigned long long u64;

constexpr int NB = 4, SEQ = 4096, MTOK = NB * SEQ, DM = 2048, NH = 12, HD = 128, MIXW = 1536, MEMW = 512, INW = 5120, FF = 8192, MEMT = 256;
constexpr int QKW = 3584;
constexpr float LOG2E = 1.4426950408889634f;
constexpr float EPS = 1e-6f;
constexpr float SSQ_FIX = 16777216.0f;

constexpr size_t MiB = 1u << 20;
constexpr size_t WS_CTL = 0;
constexpr size_t CTL_BYTES = 1 * MiB;
constexpr size_t SSQ_OFF = 64 * 1024;
constexpr size_t WS_LSE = 1 * MiB;
constexpr size_t WS_KM = 4 * MiB;
constexpr size_t WS_WIN = 8 * MiB, WS_WOUT = 28 * MiB, WS_W1 = 36 * MiB, WS_W2 = 68 * MiB;
constexpr size_t WS_XB = 100 * MiB;
constexpr size_t WS_BIG = 164 * MiB;
constexpr size_t WS_QK = WS_BIG, WS_VT = WS_BIG + 112 * MiB, WS_MRG = WS_BIG + 160 * MiB;
constexpr size_t WS_WL1 = 412 * MiB;
constexpr size_t WS_END = 512 * MiB;

__device__ __forceinline__ unsigned cvt_pk_bf16(float lo, float hi) { unsigned r; asm("v_cvt_pk_bf16_f32 %0, %1, %2" : "=v"(r) : "v"(lo), "v"(hi)); return r; }
__device__ __forceinline__ float bf_lo(unsigned w) { return __uint_as_float(w << 16); }
__device__ __forceinline__ float bf_hi(unsigned w) { return __uint_as_float(w & 0xffff0000u); }
__device__ __forceinline__ float wave_sum(float v) {
#pragma unroll
    for (int o = 1; o < 64; o <<= 1) v += __shfl_xor(v, o);
    return v;
}
__device__ __forceinline__ float swap32(float v) { return __shfl_xor(v, 32); }
__device__ __forceinline__ float rstd_of(u64 s) { return rsqrtf((float)s * (1.0f / (SSQ_FIX * (float)DM)) + EPS); }

namespace pg8 {
constexpr int BM = 256, BK = 64, HALF = 128, HTB = HALF * BK * 2, STAGE_BYTES = 8 * HTB;
__device__ __forceinline__ int lds_byte(int r, int c) { const int st = (r >> 4) * 2 + (c >> 5), rr = r & 15, cc = c & 31, ob = rr * 64 + cc * 2; return st * 1024 + (ob ^ (((ob >> 9) & 1) << 5)); }
__device__ __forceinline__ void stage_rc(int b, int& R, int& C) { const int st = b / 1024, sb = b % 1024, swz = sb ^ (((sb >> 9) & 1) << 5); R = (st >> 1) * 16 + swz / 64; C = (st & 1) * 32 + (swz % 64) / 2; }
__device__ __forceinline__ int perm32(int rho) { const int n = rho >> 4, i = rho & 15; return 8 * (i >> 2) + 4 * n + (i & 3); }

struct Unit { int pm, pn, kind, bstr, brow; const char* a; const char* b; };

template <class Epi, class Sched>
__device__ __forceinline__ void gemm_phase(LAS unsigned char* lds, const int K, const Sched& S, const Epi& E) {
    int tid = threadIdx.x; asm volatile("" : "+v"(tid));
    const int wid = __builtin_amdgcn_readfirstlane(tid >> 6), lane = tid & 63, wr = wid >> 2, wc = wid & 3, fr = lane & 15, fq = lane >> 4;
    const int nt = K / BK;
    unsigned voffA[2];
#pragma unroll
    for (int i = 0; i < 2; ++i) { int R, C; stage_rc(tid * 16 + i * 8192, R, C); voffA[i] = (unsigned)(R * K + C) * 2u; }
#define PG8_VOFFB(dst, bstr_) do { int tt_ = tid; asm volatile("" : "+v"(tt_)); _Pragma("unroll") for (int i = 0; i < 2; ++i) { int R, C; stage_rc(tt_ * 16 + i * 8192, R, C); \
        const int Rb = (R & ~31) + perm32(R & 31); dst[i] = (unsigned)(Rb * K * (bstr_) + C) * 2u; } } while (0)
    const size_t kstep = (size_t)(BK * 2);
    const size_t hstepA = (size_t)HALF * K * 2;
    const unsigned ldsw = (unsigned)wid * 1024u;
    const int aoff = lds_byte(wr * 64 + fr, fq * 8), boff = lds_byte(wc * 32 + fr, fq * 8);
#define PG8_SA(b, h) (((b) * 2 + (h)) * HTB)
#define PG8_SB(b, h) ((4 + (b) * 2 + (h)) * HTB)
#define PG8_STAGE(bufoff, gbase, voff) do { _Pragma("unroll") for (int _i = 0; _i < 2; ++_i) \
        __builtin_amdgcn_global_load_lds((const unsigned*)((const char*)(gbase) + (voff)[_i]), (LAS unsigned*)(lds + (bufoff) + ldsw + _i * 8192), 16, 0, 0); } while (0)
#define PG8_LDA(dst, b, h) do { _Pragma("unroll") for (int m = 0; m < 4; ++m) _Pragma("unroll") for (int k = 0; k < 2; ++k) dst[m][k] = *(const LAS bf16x8*)(lds + PG8_SA(b, h) + aoff + m * 2048 + k * 1024); } while (0)
#define PG8_LDB(dst, b, h) do { _Pragma("unroll") for (int n = 0; n < 2; ++n) _Pragma("unroll") for (int k = 0; k < 2; ++k) dst[n][k] = *(const LAS bf16x8*)(lds + PG8_SB(b, h) + boff + n * 2048 + k * 1024); } while (0)
#define PG8_MMA(ai, bj, At, Bt) do { __builtin_amdgcn_s_setprio(1); _Pragma("unroll") for (int m = 0; m < 4; ++m) _Pragma("unroll") for (int n = 0; n < 2; ++n) _Pragma("unroll") for (int k = 0; k < 2; ++k) \
        acc[ai][bj][m][n] = __builtin_amdgcn_mfma_f32_16x16x32_bf16(Bt[n][k], At[m][k], acc[ai][bj][m][n], 0, 0, 0); __builtin_amdgcn_s_setprio(0); } while (0)
#define PG8_WAIT_V(n) asm volatile("s_waitcnt vmcnt(" #n ")" ::: "memory")
#define PG8_WAIT_L(n) asm volatile("s_waitcnt lgkmcnt(" #n ")" ::: "memory")
#define PG8_BAR __builtin_amdgcn_s_barrier()
#define PG8_SCHED __builtin_amdgcn_sched_barrier(0)
    Unit cur, nxt; int ui = 0;
    if (!S.next(0, cur)) return;
    f32x4 acc[2][2][4][2];
#pragma unroll
    for (int a = 0; a < 2; ++a)
#pragma unroll
        for (int b = 0; b < 2; ++b)
#pragma unroll
            for (int m = 0; m < 4; ++m)
#pragma unroll
                for (int n = 0; n < 2; ++n) acc[a][b][m][n] = (f32x4){0.f, 0.f, 0.f, 0.f};
    bf16x8 At[4][2], B0[2][2], B1[2][2];
    const char* cA = cur.a; const char* cB = cur.b;
    unsigned voffB[2]; PG8_VOFFB(voffB, cur.bstr);
    size_t hstepB = hstepA * (size_t)cur.bstr;
    PG8_STAGE(PG8_SB(0, 0), cB, voffB); PG8_STAGE(PG8_SB(0, 1), cB + hstepB, voffB); PG8_STAGE(PG8_SA(0, 0), cA, voffA); PG8_STAGE(PG8_SA(0, 1), cA + hstepA, voffA);
    if (wr == 1) PG8_BAR;
    PG8_WAIT_V(2); PG8_BAR;
    PG8_STAGE(PG8_SB(1, 0), cB + kstep, voffB); PG8_STAGE(PG8_SA(1, 0), cA + kstep, voffA); PG8_STAGE(PG8_SB(1, 1), cB + hstepB + kstep, voffB);
    PG8_WAIT_V(6); PG8_BAR;
    for (;;) {
        const bool has_next = S.next(ui + 1, nxt);
        const char* nA = has_next ? nxt.a : cA; const char* nB = has_next ? nxt.b : cB;
        const int nbstr = has_next ? nxt.bstr : cur.bstr;
        for (int t = 0; t < nt; t += 2) {
            const bool last = (t == nt - 2);
            const char* a1 = cA + (size_t)(t + 1) * kstep;
            const char* a2 = last ? nA : cA + (size_t)(t + 2) * kstep; const char* b2 = last ? nB : cB + (size_t)(t + 2) * kstep;
            const char* a3 = a2 + kstep; const char* b3 = b2 + kstep;
            if (last) { PG8_VOFFB(voffB, nbstr); hstepB = hstepA * (size_t)nbstr; }
            PG8_LDB(B0, 0, 0); PG8_LDB(B1, 0, 1); PG8_SCHED; PG8_LDA(At, 0, 0); PG8_STAGE(PG8_SA(1, 1), a1 + hstepA, voffA);
            PG8_WAIT_V(8); PG8_WAIT_L(0); PG8_BAR; PG8_MMA(0, 0, At, B0); PG8_MMA(0, 1, At, B1); PG8_BAR; PG8_SCHED;
            PG8_LDA(At, 0, 1); PG8_STAGE(PG8_SB(0, 0), b2, voffB); PG8_STAGE(PG8_SB(0, 1), b2 + hstepB, voffB); PG8_STAGE(PG8_SA(0, 0), a2, voffA);
            PG8_WAIT_V(8); PG8_WAIT_L(0); PG8_BAR; PG8_MMA(1, 0, At, B0); PG8_MMA(1, 1, At, B1); PG8_BAR; PG8_SCHED;
            PG8_LDB(B0, 1, 0); PG8_LDB(B1, 1, 1); PG8_SCHED; PG8_LDA(At, 1, 0); PG8_STAGE(PG8_SA(0, 1), a2 + hstepA, voffA);
            PG8_WAIT_V(8); PG8_WAIT_L(0); PG8_BAR; PG8_MMA(0, 0, At, B0); PG8_MMA(0, 1, At, B1); PG8_BAR; PG8_SCHED;
            PG8_LDA(At, 1, 1); PG8_STAGE(PG8_SB(1, 0), b3, voffB); PG8_STAGE(PG8_SB(1, 1), b3 + hstepB, voffB); PG8_STAGE(PG8_SA(1, 0), a3, voffA);
            PG8_WAIT_V(8); PG8_WAIT_L(0); PG8_BAR; PG8_MMA(1, 0, At, B0); PG8_MMA(1, 1, At, B1); PG8_BAR; PG8_SCHED;
        }
        if (wr == 0) PG8_BAR;
        E(acc, cur, wr, wc, fr, fq);
        if (!has_next) break;
#pragma unroll
        for (int a = 0; a < 2; ++a)
#pragma unroll
            for (int b = 0; b < 2; ++b)
#pragma unroll
                for (int m = 0; m < 4; ++m)
#pragma unroll
                    for (int n = 0; n < 2; ++n) acc[a][b][m][n] = (f32x4){0.f, 0.f, 0.f, 0.f};
        cur = nxt; cA = nA; cB = nB; ++ui;
        if (wr == 1) PG8_BAR;
    }
    PG8_WAIT_V(0);
    PG8_BAR;
#undef PG8_SA
#undef PG8_SB
#undef PG8_STAGE
#undef PG8_LDA
#undef PG8_LDB
#undef PG8_MMA
#undef PG8_WAIT_V
#undef PG8_WAIT_L
#undef PG8_BAR
#undef PG8_SCHED
#undef PG8_VOFFB
}

struct SchedPlain {
    const char* A; const char* Bt; int nN, K, G, c;
    __device__ __forceinline__ bool next(int i, Unit& u) const {
        const int L = i * G + c; if (L >= 64 * nN) return false;
        const int xcd = L & 7, idx = L >> 3;
        u.pm = 8 * xcd + (idx & 7); u.pn = idx >> 3; u.kind = 0; u.bstr = 1; u.brow = 0;
        u.a = A + (size_t)u.pm * 256 * K * 2; u.b = Bt + (size_t)u.pn * 256 * K * 2; return true;
    }
};
struct SchedProj {
    const char* XB; const char* WT; int layer, G, c;
    __device__ __forceinline__ bool next(int i, Unit& u) const {
        const int L = i * G + c; if (L >= 1280) return false;
        const int xcd = L & 7, idx = L >> 3;
        constexpr int K = DM;
        if (idx < 112) {
            u.pm = 8 * xcd + (idx & 7); u.pn = idx >> 3; u.kind = 0; u.bstr = 1; u.brow = 0;
            u.a = XB + (size_t)u.pm * 256 * K * 2; u.b = WT + (size_t)u.pn * 256 * K * 2;
        } else {
            const int j2 = idx - 112; u.pm = j2 >> 3; u.pn = 8 * xcd + (j2 & 7); u.kind = 1;
            const int g = u.pm >> 1; const int dl = (layer == 1) ? (g == 0 ? 1 : (g == 1 ? 4 : 16)) : 1;
            const int b = u.pn >> 4, j = u.pn & 15, tpc = 16 / dl, r = j / tpc, cc = j % tpc;
            u.bstr = dl; u.brow = b * SEQ + dl * 256 * cc + r;
            u.a = WT + (size_t)(QKW + 256 * u.pm) * K * 2; u.b = XB + (size_t)u.brow * K * 2;
        }
        return true;
    }
};

struct EpiProj {
    bf16_t* QK; bf16_t* VT; const u64* ssq; float qscale_mix, qscale_mem; int layer;
    __device__ __forceinline__ void operator()(const f32x4 (&acc)[2][2][4][2], const Unit& u, int wr, int wc, int fr, int fq) const {
        if (u.kind == 0) {
            const int row0 = u.pm * 256 + wr * 64 + fr, col0 = u.pn * 256 + wc * 32 + 8 * fq;
            const float cs = (u.pn < 6) ? qscale_mix : ((u.pn >= 12) ? qscale_mem : 1.0f);
            const bool kfrag = (layer == 1) && (u.pn >= 6) && (u.pn < 12);
            const int qkw = layer == 0 ? QKW : 2048, cofs = (layer == 1 && u.pn >= 12) ? 1536 : 0;
            bf16_t* KF = QK + 32 * MiB;
#pragma unroll
            for (int ai = 0; ai < 2; ++ai)
#pragma unroll
                for (int m = 0; m < 4; ++m) { const int row = row0 + ai * 128 + m * 16; const float rs = rstd_of(ssq[row]) * cs;
#pragma unroll
                    for (int bj = 0; bj < 2; ++bj) { const f32x4 v0 = acc[ai][bj][m][0] * rs, v1 = acc[ai][bj][m][1] * rs; u32x4 w;
                        w.x = cvt_pk_bf16(v0[0], v0[1]); w.y = cvt_pk_bf16(v0[2], v0[3]); w.z = cvt_pk_bf16(v1[0], v1[1]); w.w = cvt_pk_bf16(v1[2], v1[3]);
                        if (!kfrag) *(u32x4*)(QK + (size_t)row * qkw + col0 - cofs + bj * 128) = w;
                        else { const int h = (u.pn - 6) * 2 + bj, g = h >> 2, dl = g == 0 ? 1 : (g == 1 ? 4 : 16), sh = g == 0 ? 0 : (g == 1 ? 2 : 4);
                            const int b = row >> 12, tok = row & 4095, r = tok & (dl - 1), n = tok >> sh, rr = n & 31, ctile = r * (128 >> sh) + (n >> 5);
                            const int d0 = wc * 2 + (fq >> 1), hip = fq & 1, prw = (rr & 19) | ((rr & 4) << 1) | ((rr & 8) >> 1);
                            *(u32x4*)(KF + (size_t)(b * NH + h) * 524288 + (size_t)((ctile * 8 + d0) * 64 + hip * 32 + prw) * 8) = w; } } }
        } else {
            const int row0 = u.pm * 256 + wr * 64 + fr, cin0 = wc * 32 + 8 * fq;
            float rs[2][8];
#pragma unroll
            for (int bj = 0; bj < 2; ++bj)
#pragma unroll
                for (int e = 0; e < 8; ++e) rs[bj][e] = rstd_of(ssq[u.brow + (cin0 + bj * 128 + e) * u.bstr]);
#pragma unroll
            for (int ai = 0; ai < 2; ++ai)
#pragma unroll
                for (int m = 0; m < 4; ++m) { const int row = row0 + ai * 128 + m * 16;
#pragma unroll
                    for (int bj = 0; bj < 2; ++bj) { const f32x4 a0 = acc[ai][bj][m][0], a1 = acc[ai][bj][m][1]; u32x4 w;
                        w.x = cvt_pk_bf16(a0[0] * rs[bj][0], a0[1] * rs[bj][1]); w.y = cvt_pk_bf16(a0[2] * rs[bj][2], a0[3] * rs[bj][3]);
                        w.z = cvt_pk_bf16(a1[0] * rs[bj][4], a1[1] * rs[bj][5]); w.w = cvt_pk_bf16(a1[2] * rs[bj][6], a1[3] * rs[bj][7]);
                        if (layer == 0) *(u32x4*)(VT + (size_t)row * MTOK + u.pn * 256 + cin0 + bj * 128) = w;
                        else { const int h = row >> 7, dd = row & 127, db = dd >> 5, rr = dd & 31, b = u.pn >> 4, P = 256 * (u.pn & 15) + cin0 + bj * 128;
                            *(u32x4*)(VT + (size_t)(b * NH + h) * 524288 + (size_t)((((P >> 5) * 4 + db) * 2 + ((P >> 4) & 1)) * 64 + ((P >> 3) & 1) * 32 + rr) * 8) = w; } } }
        }
    }
};
struct EpiRelu2 {
    bf16_t* H; const u64* ssq;
    __device__ __forceinline__ void operator()(const f32x4 (&acc)[2][2][4][2], const Unit& u, int wr, int wc, int fr, int fq) const {
        const int row0 = u.pm * 256 + wr * 64 + fr, col0 = u.pn * 256 + wc * 32 + 8 * fq;
#pragma unroll
        for (int ai = 0; ai < 2; ++ai)
#pragma unroll
            for (int m = 0; m < 4; ++m) { const int row = row0 + ai * 128 + m * 16; const float rs = rstd_of(ssq[row]); bf16_t* rowp = H + (size_t)row * FF + col0;
#pragma unroll
                for (int bj = 0; bj < 2; ++bj) { f32x4 v0 = acc[ai][bj][m][0] * rs, v1 = acc[ai][bj][m][1] * rs;
#pragma unroll
                    for (int e = 0; e < 4; ++e) { const float a = fmaxf(v0[e], 0.f), b = fmaxf(v1[e], 0.f); v0[e] = a * a; v1[e] = b * b; }
                    u32x4 w; w.x = cvt_pk_bf16(v0[0], v0[1]); w.y = cvt_pk_bf16(v0[2], v0[3]); w.z = cvt_pk_bf16(v1[0], v1[1]); w.w = cvt_pk_bf16(v1[2], v1[3]);
                    *(u32x4*)(rowp + bj * 128) = w; } }
    }
};
struct EpiRes {
    bf16_t* xb; u64* ssq;
    __device__ __forceinline__ void operator()(const f32x4 (&acc)[2][2][4][2], const Unit& u, int wr, int wc, int fr, int fq) const {
        const int row0 = u.pm * 256 + wr * 64 + fr, col0 = u.pn * 256 + wc * 32 + 8 * fq;
#pragma unroll
        for (int ai = 0; ai < 2; ++ai)
#pragma unroll
            for (int m = 0; m < 4; ++m) { const int row = row0 + ai * 128 + m * 16; const size_t off = (size_t)row * DM + col0; float ss = 0.f;
#pragma unroll
                for (int bj = 0; bj < 2; ++bj) {
                    const u32x4 xo = *(const u32x4*)(xb + off + bj * 128);
                    const f32x4 v0 = (f32x4){bf_lo(xo.x), bf_hi(xo.x), bf_lo(xo.y), bf_hi(xo.y)} + acc[ai][bj][m][0], v1 = (f32x4){bf_lo(xo.z), bf_hi(xo.z), bf_lo(xo.w), bf_hi(xo.w)} + acc[ai][bj][m][1];
                    u32x4 w; w.x = cvt_pk_bf16(v0[0], v0[1]); w.y = cvt_pk_bf16(v0[2], v0[3]); w.z = cvt_pk_bf16(v1[0], v1[1]); w.w = cvt_pk_bf16(v1[2], v1[3]);
                    *(u32x4*)(xb + off + bj * 128) = w;
                    ss += (v0[0] * v0[0] + v0[1] * v0[1]) + (v0[2] * v0[2] + v0[3] * v0[3]) + (v1[0] * v1[0] + v1[1] * v1[1]) + (v1[2] * v1[2] + v1[3] * v1[3]); }
                ss += __shfl_xor(ss, 16); ss += __shfl_xor(ss, 32);
                if (fq == 0) atomicAdd((u64*)(ssq + row), (u64)(ss * SSQ_FIX));
                asm volatile("" ::: "memory"); }
    }
};
}

struct Params {
    const float *x, *mem, *g_attn, *w_in, *w_out, *lambda_qk, *subln_g, *g_mem, *w_mem_kv, *g_mlp, *w_mlp1, *w_mlp2, *g_final;
    float* out; unsigned char* ws;
};

constexpr int NWAVES = 8;
constexpr int LDS_BYTES = 147456;

__device__ __forceinline__ void transpose_item(const float* __restrict__ W, int K, int N, bf16_t* __restrict__ WT, const float* __restrict__ g, int permute_in, int item, int lane) {
    const int nblk = N / 64, kb = item / nblk, nb = item % nblk, k0 = 64 * kb, n0 = 64 * nb;
    const float* src = W + (size_t)k0 * N + n0 + lane;
    float v[64];
#pragma unroll
    for (int i = 0; i < 64; ++i) v[i] = src[(size_t)i * N];
    if (g) {
#pragma unroll
        for (int i = 0; i < 64; ++i) v[i] *= g[k0 + i];
    }
    int nr0 = n0;
    if (permute_in) { if (n0 >= 4608) nr0 = n0 - 1536; else if (n0 >= 3072) nr0 = n0 + 512; }
    u32x4* dst = (u32x4*)(WT + (size_t)(nr0 + lane) * K + k0);
#pragma unroll
    for (int c = 0; c < 8; ++c) { u32x4 o; o.x = cvt_pk_bf16(v[8 * c], v[8 * c + 1]); o.y = cvt_pk_bf16(v[8 * c + 2], v[8 * c + 3]); o.z = cvt_pk_bf16(v[8 * c + 4], v[8 * c + 5]); o.w = cvt_pk_bf16(v[8 * c + 6], v[8 * c + 7]); dst[c] = o; }
}
__device__ __forceinline__ void phase_weights(const Params& p, int layer, LAS unsigned char* lds, int gw, int NGW, int wave, int lane) {
    asm volatile("" : "+v"(lane));
    unsigned char* ws = p.ws + (size_t)layer * WS_WL1;
    constexpr int I_IN = (DM / 64) * (INW / 64), I_OUT = (DM / 64) * (DM / 64), I_1 = (DM / 64) * (FF / 64), I_2 = (FF / 64) * (DM / 64);
    constexpr int NITEMS = I_IN + I_OUT + I_1 + I_2;
    for (int it = gw; it < NITEMS; it += NGW) {
        int r = it;
        if (r < I_IN) { transpose_item(p.w_in + (size_t)layer * DM * INW, DM, INW, (bf16_t*)(ws + WS_WIN), p.g_attn + layer * DM, 1, r, lane); continue; } r -= I_IN;
        if (r < I_OUT) { transpose_item(p.w_out + (size_t)layer * DM * DM, DM, DM, (bf16_t*)(ws + WS_WOUT), nullptr, 0, r, lane); continue; } r -= I_OUT;
        if (r < I_1) { transpose_item(p.w_mlp1 + (size_t)layer * DM * FF, DM, FF, (bf16_t*)(ws + WS_W1), p.g_mlp + layer * DM, 0, r, lane); continue; } r -= I_1;
        transpose_item(p.w_mlp2 + (size_t)layer * FF * DM, FF, DM, (bf16_t*)(ws + WS_W2), nullptr, 0, r, lane);
    }
}
__device__ __forceinline__ void phase_xprep(const Params& p, int gw, int NGW, int lane) {
    asm volatile("" : "+v"(lane));
    bf16_t* XB = (bf16_t*)(p.ws + WS_XB); u64* ssq = (u64*)(p.ws + SSQ_OFF);
    for (int m = gw; m < MTOK; m += NGW) {
        const f32x4* xr = (const f32x4*)(p.x + (size_t)m * DM) + lane; f32x4 v[8]; float s = 0.f;
#pragma unroll
        for (int j = 0; j < 8; ++j) { v[j] = xr[64 * j]; s += (v[j].x * v[j].x + v[j].y * v[j].y) + (v[j].z * v[j].z + v[j].w * v[j].w); }
        s = wave_sum(s);
        if (lane == 0) ssq[m] = (u64)(s * SSQ_FIX);
        u32x2* o8 = (u32x2*)(XB + (size_t)m * DM) + lane;
#pragma unroll
        for (int j = 0; j < 8; ++j) { u32x2 w; w.x = cvt_pk_bf16(v[j].x, v[j].y); w.y = cvt_pk_bf16(v[j].z, v[j].w); o8[64 * j] = w; }
    }
}
__device__ __forceinline__ void phase_memkv(const Params& p, int gw, int NGW, int lane) {
    asm volatile("" : "+v"(lane));
    const int r32 = lane & 31, hi = lane >> 5;
    for (int it = gw; it < 2048; it += NGW) {
        const int layer = it >> 10, typ = (it >> 9) & 1, tt = it & 511;
        const int mt = typ == 0 ? (tt >> 4) : (tt & 31), nt = typ == 0 ? (tt & 15) : (tt >> 5);
        const float* mrow = p.mem + (size_t)(32 * mt + r32) * DM + 8 * hi;
        const float* wcol = p.w_mem_kv + (size_t)layer * DM * 1024 + (size_t)(8 * hi) * 1024 + typ * 512 + 32 * nt + r32;
        const float* gm = p.g_mem + 8 * hi;
        f32x16 acc = {}; float ss = 0.f;
#pragma unroll 8
        for (int k0 = 0; k0 < DM; k0 += 16) {
            const f32x4 a0 = *(const f32x4*)(mrow + k0), a1 = *(const f32x4*)(mrow + k0 + 4);
            const f32x4 g0 = *(const f32x4*)(gm + k0), g1 = *(const f32x4*)(gm + k0 + 4);
            float w[8];
#pragma unroll
            for (int j = 0; j < 8; ++j) w[j] = wcol[(size_t)(k0 + j) * 1024];
            ss += (a0.x * a0.x + a0.y * a0.y) + (a0.z * a0.z + a0.w * a0.w) + (a1.x * a1.x + a1.y * a1.y) + (a1.z * a1.z + a1.w * a1.w);
            u32x4 mf, wf;
            mf.x = cvt_pk_bf16(a0.x * g0.x, a0.y * g0.y); mf.y = cvt_pk_bf16(a0.z * g0.z, a0.w * g0.w); mf.z = cvt_pk_bf16(a1.x * g1.x, a1.y * g1.y); mf.w = cvt_pk_bf16(a1.z * g1.z, a1.w * g1.w);
            wf.x = cvt_pk_bf16(w[0], w[1]); wf.y = cvt_pk_bf16(w[2], w[3]); wf.z = cvt_pk_bf16(w[4], w[5]); wf.w = cvt_pk_bf16(w[6], w[7]);
            const bf16x8 mfr = __builtin_bit_cast(bf16x8, mf), wfr = __builtin_bit_cast(bf16x8, wf);
            if (typ == 0) acc = __builtin_amdgcn_mfma_f32_32x32x16_bf16(mfr, wfr, acc, 0, 0, 0);
            else          acc = __builtin_amdgcn_mfma_f32_32x32x16_bf16(wfr, mfr, acc, 0, 0, 0);
        }
        ss += swap32(ss);
        const float rs = rsqrtf(ss * (1.0f / DM) + EPS);
        bf16_t* KM = (bf16_t*)(p.ws + WS_KM + (size_t)layer * 2 * MiB); bf16_t* VMT = KM + 1024 * 512;
        if (typ == 0) {
            const int d = 32 * nt + r32, hm = d >> 7, dd = d & 127, d0 = dd >> 4, hip = (dd >> 3) & 1, j = dd & 7;
            const int b = mt >> 3, tile = mt & 7;
#pragma unroll
            for (int r = 0; r < 16; ++r) { const int row = (r & 3) + 8 * (r >> 2) + 4 * hi; const float rr = __shfl(rs, row);
                const int prw = (row & 19) | ((row & 4) << 1) | ((row & 8) >> 1);
                KM[((((size_t)(b * 4 + hm) * 8 + tile) * 8 + d0) * 64 + hip * 32 + prw) * 8 + j] = (bf16_t)(cvt_pk_bf16(acc[r] * rr, 0.f) & 0xffffu); }
        } else {
            const int b = mt >> 3, tile = mt & 7, s2 = (r32 >> 4) & 1, hip = (r32 >> 3) & 1, j = r32 & 7;
#pragma unroll
            for (int r = 0; r < 16; ++r) { const int row = (r & 3) + 8 * (r >> 2) + 4 * hi; const int v = 32 * nt + row, hm = v >> 7, dd = v & 127, db = dd >> 5, rr = dd & 31;
                VMT[(((((size_t)(b * 4 + hm) * 8 + tile) * 4 + db) * 2 + s2) * 64 + hip * 32 + rr) * 8 + j] = (bf16_t)(cvt_pk_bf16(acc[r] * rs, 0.f) & 0xffffu); }
        }
    }
}
__device__ __forceinline__ void phase_final(const Params& p, int gw, int NGW, int lane) {
    asm volatile("" : "+v"(lane));
    const u64* ssq = (const u64*)(p.ws + SSQ_OFF) + 4 * MTOK; const bf16_t* XB = (const bf16_t*)(p.ws + WS_XB);
    for (int m = gw; m < MTOK; m += NGW) {
        const u32x4* xr = (const u32x4*)(XB + (size_t)m * DM) + lane; f32x4* orow = (f32x4*)(p.out + (size_t)m * DM) + 2 * lane; const f32x4* gr = (const f32x4*)p.g_final + 2 * lane; const float rs = rstd_of(ssq[m]);
#pragma unroll
        for (int j = 0; j < 4; ++j) { const u32x4 v = xr[64 * j]; const f32x4 g0 = gr[128 * j], g1 = gr[128 * j + 1];
            orow[128 * j] = (f32x4){bf_lo(v.x), bf_hi(v.x), bf_lo(v.y), bf_hi(v.y)} * g0 * rs; orow[128 * j + 1] = (f32x4){bf_lo(v.z), bf_hi(v.z), bf_lo(v.w), bf_hi(v.w)} * g1 * rs; }
    }
}

__device__ __forceinline__ float alibi_slope(int h) { return h < 8 ? exp2f(-0.5f * (float)(h + 1)) : exp2f(-(float)(h - 3)); }
__device__ __forceinline__ float xhalf_max(float v) { auto rr = __builtin_amdgcn_permlane32_swap(__float_as_uint(v), __float_as_uint(v), false, false); return fmaxf(__uint_as_float(rr[0]), __uint_as_float(rr[1])); }
__device__ __forceinline__ float xhalf_sum(float v) { auto rr = __builtin_amdgcn_permlane32_swap(__float_as_uint(v), __float_as_uint(v), false, false); return __uint_as_float(rr[0]) + __uint_as_float(rr[1]); }

template <bool BIAS>
__device__ __forceinline__ void attn_core(f32x16 (&o)[4], float& m_run, float& l_run, const bf16_t* __restrict__ qrow, const bf16_t* __restrict__ ktile0, const bf16_t* __restrict__ vtile0,
                                          int t_hi, int t_lo, int qt, int iq, float slope2, int W, int lane, int hi) {
    bf16x8 qf[8], kf[8];
#pragma unroll
    for (int d0 = 0; d0 < 8; ++d0) qf[d0] = *(const bf16x8*)(qrow + 16 * d0 + 8 * hi);
    const bf16_t* kp = ktile0 + (long)t_hi * 4096 + lane * 8;
    const bf16_t* vp = vtile0 + (long)t_hi * 4096 + lane * 8;
#pragma unroll
    for (int d0 = 0; d0 < 8; ++d0) kf[d0] = *(const bf16x8*)(kp + d0 * 512);
    bf16x8 vf[4][2];
#pragma unroll
    for (int db = 0; db < 4; ++db)
#pragma unroll
        for (int s2 = 0; s2 < 2; ++s2) vf[db][s2] = *(const bf16x8*)(vp + (db * 2 + s2) * 512);
    for (int t = t_hi; t >= t_lo; --t) {
        f32x16 sc = {};
#pragma unroll
        for (int d0 = 0; d0 < 8; ++d0) sc = __builtin_amdgcn_mfma_f32_32x32x16_bf16(kf[d0], qf[d0], sc, 0, 0, 0);
        if (t > t_lo) { kp -= 4096;
#pragma unroll
            for (int d0 = 0; d0 < 8; ++d0) kf[d0] = *(const bf16x8*)(kp + d0 * 512); }
        vp -= 4096;
        float tb = 0.f;
        if (BIAS) {
            const int base = iq - 32 * t - 8 * hi;
            tb = -slope2 * (float)base;
#pragma unroll
            for (int r = 0; r < 16; ++r) sc[r] = fmaf(slope2, (float)(16 * (r >> 3) + (r & 7)), sc[r]);
            if ((t == qt) || (32 * (qt - t) + 31 > W)) {
#pragma unroll
                for (int r = 0; r < 16; ++r) { const int d = base - (16 * (r >> 3) + (r & 7)); if (d < 0 || d > W) sc[r] = -INFINITY; }
            }
        }
        float mx = fmaxf(sc[0], sc[1]);
#pragma unroll
        for (int r = 2; r < 16; ++r) mx = fmaxf(mx, sc[r]);
        const float mt = xhalf_max(mx + tb);
        if (__any(mt > m_run + 8.0f)) {
            const float mn = fmaxf(m_run, mt), f = __builtin_amdgcn_exp2f(m_run - mn);
            l_run *= f;
#pragma unroll
            for (int db = 0; db < 4; ++db)
#pragma unroll
                for (int r = 0; r < 16; ++r) o[db][r] *= f;
            m_run = mn;
        }
        const float ml = m_run - tb; float ps = 0.f;
#pragma unroll
        for (int r = 0; r < 16; ++r) { sc[r] = __builtin_amdgcn_exp2f(sc[r] - ml); ps += sc[r]; }
        l_run += ps;
        u32x4 p0, p1;
        p0.x = cvt_pk_bf16(sc[0], sc[1]); p0.y = cvt_pk_bf16(sc[2], sc[3]); p0.z = cvt_pk_bf16(sc[4], sc[5]); p0.w = cvt_pk_bf16(sc[6], sc[7]);
        p1.x = cvt_pk_bf16(sc[8], sc[9]); p1.y = cvt_pk_bf16(sc[10], sc[11]); p1.z = cvt_pk_bf16(sc[12], sc[13]); p1.w = cvt_pk_bf16(sc[14], sc[15]);
        const bf16x8 pf0 = __builtin_bit_cast(bf16x8, p0), pf1 = __builtin_bit_cast(bf16x8, p1);
#pragma unroll
        for (int db = 0; db < 4; ++db) { o[db] = __builtin_amdgcn_mfma_f32_32x32x16_bf16(vf[db][0], pf0, o[db], 0, 0, 0); o[db] = __builtin_amdgcn_mfma_f32_32x32x16_bf16(vf[db][1], pf1, o[db], 0, 0, 0); }
        if (t > t_lo) {
#pragma unroll
            for (int db = 0; db < 4; ++db)
#pragma unroll
                for (int s2 = 0; s2 < 2; ++s2) vf[db][s2] = *(const bf16x8*)(vp + (db * 2 + s2) * 512);
        }
    }
}
__device__ __forceinline__ void store_o(bf16_t* dst, const f32x16 (&o)[4], float scale, int hi) {
#pragma unroll
    for (int db = 0; db < 4; ++db)
#pragma unroll
        for (int g4 = 0; g4 < 4; ++g4) { u32x2 w; w.x = cvt_pk_bf16(o[db][4 * g4] * scale, o[db][4 * g4 + 1] * scale); w.y = cvt_pk_bf16(o[db][4 * g4 + 2] * scale, o[db][4 * g4 + 3] * scale);
            *(u32x2*)(dst + 32 * db + 8 * g4 + 4 * hi) = w; }
}
__device__ __forceinline__ void attn_mem_unit(const Params& p, int layer, int pair, int qt, int lane, int r32, int hi) {
    const bf16_t* QK = (const bf16_t*)(p.ws + WS_QK); const bf16_t* KMF = (const bf16_t*)(p.ws + WS_KM + (size_t)layer * 2 * MiB); const bf16_t* VMF = KMF + 1024 * 512; bf16_t* MRG = (bf16_t*)(p.ws + WS_MRG);
    const int b = pair >> 2, hm = pair & 3; const long token = (long)b * SEQ + 32 * qt + r32;
    const int qkw = layer == 0 ? QKW : 2048, qmo = layer == 0 ? 3072 : 1536;
    f32x16 o[4] = {}; float m = -INFINITY, l = 0.f;
    attn_core<false>(o, m, l, QK + token * qkw + qmo + hm * 128, KMF + (long)pair * 32768, VMF + (long)pair * 32768, 7, 0, 0, 0, 0.f, 0, lane, hi);
    const float inv = 1.0f / xhalf_sum(l);
    store_o(MRG + token * DM + MIXW + hm * 128, o, inv, hi);
}
constexpr int DA_KPITCH = 144, DA_VOFF = 64 * DA_KPITCH, DA_BUF = DA_VOFF + 128 * DA_KPITCH, DA_STASH = 57344, DA_WORD = DA_STASH + 8 * 8192;
__device__ __forceinline__ void diff_block_unit(const Params& p, int bh, int qb, float lam, LAS unsigned char* lds, int& cur, int tid, int wave, int lane, int r32, int hi) {
    const bf16_t* QK = (const bf16_t*)(p.ws + WS_QK); const bf16_t* VT = (const bf16_t*)(p.ws + WS_VT); bf16_t* MRG = (bf16_t*)(p.ws + WS_MRG);
    const int b = bh / NH, h = bh % NH; const int Q0 = 256 * qb + 32 * wave, iq = Q0 + r32; const long token = (long)b * SEQ + iq;
    const float slope2 = alibi_slope(h) * LOG2E;
    LAS unsigned* stash = (LAS unsigned*)(lds + DA_STASH + wave * 8192);
    const int krow = tid >> 3, kch = tid & 7, vrow = tid >> 2, vq4 = tid & 3;
    const bf16_t* kg = QK + ((long)b * SEQ + krow) * QKW + MIXW + h * 128 + 8 * kch;
    const bf16_t* vg = VT + (long)(h * 128 + vrow) * MTOK + (long)b * SEQ + 16 * vq4;
    const int kdst = krow * DA_KPITCH + kch * 16, vdst = DA_VOFF + vrow * DA_KPITCH + vq4 * 32;
    const int prow = (r32 & 19) | ((r32 & 4) << 1) | ((r32 & 8) >> 1);
    const int kread = prow * DA_KPITCH + 16 * hi, vread = DA_VOFF + r32 * DA_KPITCH + 16 * hi;
    const int NT = 4 * qb + 4;
    f32x16 o[4], biasv;
#pragma unroll
    for (int r = 0; r < 16; ++r) biasv[r] = slope2 * (float)(8 * hi + 16 * (r >> 3) + (r & 7));
#pragma unroll 1
    for (int mi = 0; mi < 2; ++mi) {
        const int map = 1 - mi;
        bf16x8 qf[4];
#pragma unroll
        for (int d0 = 0; d0 < 4; ++d0) qf[d0] = *(const bf16x8*)(QK + token * QKW + h * 128 + 64 * map + 16 * d0 + 8 * hi);
#pragma unroll
        for (int db = 0; db < 4; ++db) o[db] = (f32x16){};
        float m_run = -INFINITY, l_run = 0.f;
        const bf16_t* kgp = kg + 64 * map + (long)(NT - 1) * 64 * QKW; const bf16_t* vgp = vg + 64 * (NT - 1);
        u32x4 kreg = *(const u32x4*)kgp, vreg0 = *(const u32x4*)vgp, vreg1 = *(const u32x4*)(vgp + 8);
        for (int t = NT - 1; t >= 0; --t) {
            LAS unsigned char* bufp = lds + cur * DA_BUF;
            *(LAS u32x4*)(bufp + kdst) = kreg; *(LAS u32x4*)(bufp + vdst) = vreg0; *(LAS u32x4*)(bufp + vdst + 16) = vreg1;
            __syncthreads();
            if (t > 0) { kgp -= 64 * QKW; vgp -= 64; kreg = *(const u32x4*)kgp; vreg0 = *(const u32x4*)vgp; vreg1 = *(const u32x4*)(vgp + 8); }
#pragma unroll
            for (int s32 = 1; s32 >= 0; --s32) {
                const int n0 = 64 * t + 32 * s32;
                if (n0 <= Q0) {
                    bf16x8 kf[4];
#pragma unroll
                    for (int d0 = 0; d0 < 4; ++d0) kf[d0] = *(const LAS bf16x8*)(bufp + kread + 32 * s32 * DA_KPITCH + 32 * d0);
                    f32x16 sc = __builtin_amdgcn_mfma_f32_32x32x16_bf16(kf[0], qf[0], biasv, 0, 0, 0);
#pragma unroll
                    for (int d0 = 1; d0 < 4; ++d0) sc = __builtin_amdgcn_mfma_f32_32x32x16_bf16(kf[d0], qf[d0], sc, 0, 0, 0);
                    const int base = iq - n0 - 8 * hi;
                    const float tb = slope2 * (float)(n0 - 256 * qb - 256);
                    if (n0 == Q0) {
#pragma unroll
                        for (int r = 0; r < 16; ++r) { if (base - (16 * (r >> 3) + (r & 7)) < 0) sc[r] = -INFINITY; }
                    }
                    float mx = fmaxf(sc[0], sc[1]);
#pragma unroll
                    for (int r = 2; r < 16; ++r) mx = fmaxf(mx, sc[r]);
                    const float mt = xhalf_max(mx + tb);
                    if (__any(mt > m_run + 8.0f)) {
                        const float mn = fmaxf(m_run, mt), f = __builtin_amdgcn_exp2f(m_run - mn);
                        l_run *= f;
#pragma unroll
                        for (int db = 0; db < 4; ++db)
#pragma unroll
                            for (int r = 0; r < 16; ++r) o[db][r] *= f;
                        m_run = mn;
                    }
                    const float ml = m_run - tb; float ps = 0.f;
#pragma unroll
                    for (int r = 0; r < 16; ++r) { sc[r] = __builtin_amdgcn_exp2f(sc[r] - ml); ps += sc[r]; }
                    l_run += ps;
                    u32x4 p0, p1;
                    p0.x = cvt_pk_bf16(sc[0], sc[1]); p0.y = cvt_pk_bf16(sc[2], sc[3]); p0.z = cvt_pk_bf16(sc[4], sc[5]); p0.w = cvt_pk_bf16(sc[6], sc[7]);
                    p1.x = cvt_pk_bf16(sc[8], sc[9]); p1.y = cvt_pk_bf16(sc[10], sc[11]); p1.z = cvt_pk_bf16(sc[12], sc[13]); p1.w = cvt_pk_bf16(sc[14], sc[15]);
                    const bf16x8 pf0 = __builtin_bit_cast(bf16x8, p0), pf1 = __builtin_bit_cast(bf16x8, p1);
#pragma unroll
                    for (int db = 0; db < 4; ++db) {
                        const bf16x8 v0 = *(const LAS bf16x8*)(bufp + vread + 32 * db * DA_KPITCH + 64 * s32), v1 = *(const LAS bf16x8*)(bufp + vread + 32 * db * DA_KPITCH + 64 * s32 + 32);
                        o[db] = __builtin_amdgcn_mfma_f32_32x32x16_bf16(v0, pf0, o[db], 0, 0, 0); o[db] = __builtin_amdgcn_mfma_f32_32x32x16_bf16(v1, pf1, o[db], 0, 0, 0);
                    }
                }
            }
            cur ^= 1;
        }
        const float inv = 1.0f / xhalf_sum(l_run);
        if (mi == 0) {
            const float li = lam * inv;
#pragma unroll
            for (int db = 0; db < 4; ++db)
#pragma unroll
                for (int j = 0; j < 8; ++j) stash[(db * 8 + j) * 64 + lane] = cvt_pk_bf16(o[db][2 * j] * li, o[db][2 * j + 1] * li);
        } else {
#pragma unroll
            for (int db = 0; db < 4; ++db)
#pragma unroll
                for (int j = 0; j < 8; ++j) { const unsigned w = stash[(db * 8 + j) * 64 + lane]; o[db][2 * j] = o[db][2 * j] * inv - bf_lo(w); o[db][2 * j + 1] = o[db][2 * j + 1] * inv - bf_hi(w); }
        }
    }
    float ss = 0.f;
#pragma unroll
    for (int db = 0; db < 4; ++db)
#pragma unroll
        for (int r = 0; r < 16; ++r) ss += o[db][r] * o[db][r];
    ss = xhalf_sum(ss);
    const float rs = rsqrtf(ss * (1.0f / HD) + EPS) * 0.8f;
    bf16_t* dst = MRG + token * DM + h * 128;
#pragma unroll
    for (int db = 0; db < 4; ++db)
#pragma unroll
        for (int g4 = 0; g4 < 4; ++g4) { const f32x4 g = *(const f32x4*)(p.subln_g + 32 * db + 8 * g4 + 4 * hi); u32x2 w;
            w.x = cvt_pk_bf16(o[db][4 * g4] * rs * g.x, o[db][4 * g4 + 1] * rs * g.y); w.y = cvt_pk_bf16(o[db][4 * g4 + 2] * rs * g.z, o[db][4 * g4 + 3] * rs * g.w);
            *(u32x2*)(dst + 32 * db + 8 * g4 + 4 * hi) = w; }
}
__device__ __forceinline__ void attn_dil_unit(const Params& p, int bh, int u, int lane, int r32, int hi) {
    const bf16_t* QK = (const bf16_t*)(p.ws + WS_QK); const bf16_t* KF = (const bf16_t*)(p.ws + WS_QK + 64 * MiB); const bf16_t* VF = (const bf16_t*)(p.ws + WS_VT); bf16_t* MRG = (bf16_t*)(p.ws + WS_MRG); float* LSE = (float*)(p.ws + WS_LSE);
    const int b = bh / NH, h = bh % NH, g = h >> 2, dl = g == 0 ? 1 : (g == 1 ? 4 : 16), nqb = 128 / dl;
    const int r = u / nqb, qi = u % nqb, iq = 32 * qi + r32, tok = dl * iq + r; const long token = (long)b * SEQ + tok;
    const long toff = (long)bh * 524288 + (long)(r * nqb) * 4096;
    f32x16 o[4] = {}; float m = -INFINITY, l = 0.f;
    attn_core<true>(o, m, l, QK + token * 2048 + h * 128, KF + toff, VF + toff, qi, qi >= 4 ? qi - 4 : 0, qi, iq, alibi_slope(h) * (float)dl * LOG2E, 128, lane, hi);
    const float lt = xhalf_sum(l), inv = 1.0f / lt;
    store_o(MRG + token * DM + h * 128, o, inv, hi);
    if (hi == 0) LSE[(long)(b * NH + h) * SEQ + tok] = m + __builtin_amdgcn_logf(lt);
}
__device__ __forceinline__ void phase_attn(const Params& p, int layer, LAS unsigned char* lds, int tid, int wave, int lane) {
    asm volatile("" : "+v"(lane)); asm volatile("" : "+v"(tid));
    const int r32 = lane & 31, hi = lane >> 5;
    unsigned* ctl = (unsigned*)(p.ws + WS_CTL);
    const int x0 = blockIdx.x & 7;
    if (layer == 0) {
        const float a = p.lambda_qk[lane] * p.lambda_qk[64 + lane], b2 = p.lambda_qk[128 + lane] * p.lambda_qk[192 + lane];
        const float lam = expf(wave_sum(a)) - expf(wave_sum(b2)) + 0.2f;
        volatile LAS unsigned* word = (volatile LAS unsigned*)(lds + DA_WORD);
        int cur = 0;
        for (int xs = 0; xs < 8; ++xs) {
            const int x = (x0 + xs) & 7;
            for (;;) {
                __syncthreads();
                if (tid == 0) word[0] = atomicAdd(ctl + 64 * x, 1u);
                __syncthreads();
                const unsigned idx = (unsigned)__builtin_amdgcn_readfirstlane((int)word[0]);
                if (idx >= 96u) break;
                const int grp = idx >> 5, w = idx & 31;
                diff_block_unit(p, 6 * x + 2 * grp + (w & 1), 15 - (w >> 1), lam, lds, cur, tid, wave, lane, r32, hi);
            }
        }
    }
    unsigned* ctr = ctl + (layer == 0 ? 512 : 1024);
    const unsigned nper = layer == 0 ? 256u : 1024u;
    for (int xs = 0; xs < 8; ++xs) {
        const int x = (x0 + xs) & 7;
        for (;;) {
            unsigned idx = 0; if (lane == 0) idx = atomicAdd(ctr + 64 * x, 1u);
            idx = (unsigned)__builtin_amdgcn_readfirstlane((int)idx);
            if (idx >= nper) break;
            if (idx < 256u) attn_mem_unit(p, layer, 2 * x + (idx & 1), idx >> 1, lane, r32, hi);
            else { const int id = idx - 256; attn_dil_unit(p, 6 * x + (id >> 7), id & 127, lane, r32, hi); }
        }
    }
}
__device__ __forceinline__ void phase_fixup(const Params& p, int gw, int NGW, int lane) {
    asm volatile("" : "+v"(lane));
    bf16_t* MRG = (bf16_t*)(p.ws + WS_MRG); const float* LSE = (const float*)(p.ws + WS_LSE);
    for (int token = gw; token < MTOK; token += NGW) {
        const int b = token >> 12, t = token & 4095;
#pragma unroll
        for (int j = 0; j < 3; ++j) {
            const int c = lane + 64 * j, head = c >> 4, g = head >> 2, slot = head & 3;
            const float* lp = LSE + (long)(b * NH + slot) * SEQ + t;
            const float l0 = lp[0], l1 = lp[4 * SEQ], l2 = lp[8 * SEQ], mx = fmaxf(l0, fmaxf(l1, l2));
            const float e0 = __builtin_amdgcn_exp2f(l0 - mx), e1 = __builtin_amdgcn_exp2f(l1 - mx), e2 = __builtin_amdgcn_exp2f(l2 - mx);
            const float al = (g == 0 ? e0 : (g == 1 ? e1 : e2)) / (e0 + e1 + e2);
            u32x4* ptr = (u32x4*)(MRG + (size_t)token * DM + 8 * c); u32x4 v = *ptr;
            v.x = cvt_pk_bf16(bf_lo(v.x) * al, bf_hi(v.x) * al); v.y = cvt_pk_bf16(bf_lo(v.y) * al, bf_hi(v.y) * al);
            v.z = cvt_pk_bf16(bf_lo(v.z) * al, bf_hi(v.z) * al); v.w = cvt_pk_bf16(bf_lo(v.w) * al, bf_hi(v.w) * al);
            *ptr = v;
        }
    }
}


#define XB_TMO      128
#define XB_XCNT(j)  (256  + 64 * (j))
#define XB_XSUB(j)  (1280 + 64 * (j))
#define XB_XGEN(j)  (2304 + 64 * (j))
#define XB_TOP      3328
#define XB_TOPGEN   3392
#define XCD_BAR_WORDS 3456
#define XB_SPIN_CAP (1u << 18)
__device__ __forceinline__ unsigned xb_ld(unsigned* p)              { return __hip_atomic_load(p, __ATOMIC_RELAXED, __HIP_MEMORY_SCOPE_AGENT); }
__device__ __forceinline__ unsigned xb_add(unsigned* p, unsigned v) { return __hip_atomic_fetch_add(p, v, __ATOMIC_RELAXED, __HIP_MEMORY_SCOPE_AGENT); }
__device__ __forceinline__ unsigned xb_xcc_id() { return (unsigned)__builtin_amdgcn_s_getreg((3 << 11) | 20) & 0xFu; }
#define XB_SPIN(cond, bar) do { unsigned _sp = 0; while (cond) { __builtin_amdgcn_s_sleep(1); \
    if ((++_sp & 255u) == 0u) { if (xb_ld(&(bar)[XB_TMO])) break; if (_sp > XB_SPIN_CAP) { atomicAdd(&(bar)[XB_TMO], 1u); break; } } } } while (0)
struct XcdBarrier { unsigned* bar; unsigned x; volatile LAS unsigned* st; };
__device__ __forceinline__ XcdBarrier xcd_barrier_post(unsigned* bar, volatile LAS unsigned* st) {
    XcdBarrier b; b.bar = bar; b.x = xb_xcc_id(); b.st = st;
    if (threadIdx.x == 0) (void)xb_add(&bar[XB_XCNT(b.x)], 1u);
    return b;
}
__device__ __forceinline__ void xcd_barrier_complete(unsigned* bar, unsigned x, unsigned& nloc, unsigned& nx) {
    const unsigned G = gridDim.x * gridDim.y * gridDim.z;
    unsigned sum, cnt, mine, sp = 0u;
    for (;;) {
        sum = 0u; cnt = 0u; mine = 0u;
#pragma unroll
        for (unsigned j = 0; j < 16; ++j) { const unsigned c = xb_ld(&bar[XB_XCNT(j)]); sum += c; cnt += (c > 0u) ? 1u : 0u; mine = (j == x) ? c : mine; }
        if (sum == G) break;
        __builtin_amdgcn_s_sleep(1);
        if ((++sp & 255u) == 0u) { if (xb_ld(&bar[XB_TMO])) break; if (sp > XB_SPIN_CAP) { atomicAdd(&bar[XB_TMO], 1u); break; } }
    }
    nloc = mine > 0u ? mine : 1u; nx = cnt > 0u ? cnt : 1u;
}
__device__ __forceinline__ void xcd_barrier(const XcdBarrier& b) {
    asm volatile("s_waitcnt vmcnt(0)" ::: "memory");
    __syncthreads();
    if (threadIdx.x == 0) {
        unsigned* bar = b.bar;
        __builtin_amdgcn_s_waitcnt(0);
        unsigned nloc = b.st[0], nx = b.st[1];
        if (nloc == 0u) { xcd_barrier_complete(bar, b.x, nloc, nx); b.st[0] = nloc; b.st[1] = nx; }
        const unsigned old = xb_add(&bar[XB_XSUB(b.x)], 1u);
        const unsigned gen = old / nloc;
        if (old + 1u == (gen + 1u) * nloc) {
            __builtin_amdgcn_fence(__ATOMIC_RELEASE, "agent");
            asm volatile("s_waitcnt vmcnt(0)" ::: "memory");
            const unsigned og = xb_add(&bar[XB_TOP], 1u);
            const unsigned tg = og / nx;
            if (og + 1u == (tg + 1u) * nx) xb_add(&bar[XB_TOPGEN], 1u);
            else XB_SPIN(xb_ld(&bar[XB_TOPGEN]) == tg, bar);
            __builtin_amdgcn_fence(__ATOMIC_ACQUIRE, "agent");
            xb_add(&bar[XB_XGEN(b.x)], 1u);
            asm volatile("s_waitcnt vmcnt(0)" ::: "memory");
        } else {
            XB_SPIN(xb_ld(&bar[XB_XGEN(b.x)]) == gen, bar);
            __builtin_amdgcn_fence(__ATOMIC_ACQUIRE, "agent");
            asm volatile("s_waitcnt vmcnt(0)" ::: "memory");
        }
    }
    __syncthreads();
}

__global__ void __launch_bounds__(NWAVES * 64) mega_fwd(Params p) {
    extern __shared__ __attribute__((aligned(16))) unsigned char lds_raw[];
    LAS unsigned char* lds = (LAS unsigned char*)lds_raw;
    cg::grid_group grid = cg::this_grid();
    const int tid = threadIdx.x, lane = tid & 63, wave = __builtin_amdgcn_readfirstlane(tid >> 6);
    const int G = gridDim.x, c = blockIdx.x;
    const int gw = c * NWAVES + wave, NGW = G * NWAVES;
    unsigned char* ws = p.ws;
    u64* ssq = (u64*)(ws + SSQ_OFF);
    bf16_t* XB = (bf16_t*)(ws + WS_XB);

    volatile LAS unsigned* bst = (volatile LAS unsigned*)(lds + LDS_BYTES - 64);
    if (tid < 16) bst[tid] = 0u;
    __syncthreads();
    const XcdBarrier xbar = xcd_barrier_post((unsigned*)(ws + WS_CTL) + 4096, bst);
#define GRID_BAR() xcd_barrier(xbar)
    for (int st = 0; st < 3; ++st) {
        const int k = (wave & 1) ? st : 2 - st;
        if (k == 0) phase_memkv(p, gw, NGW, lane);
        else if (k == 1) phase_weights(p, 0, lds, gw, NGW, wave, lane);
        else phase_xprep(p, gw, NGW, lane);
    }
    if (p.ws == nullptr) grid.sync();
    GRID_BAR();

    for (int layer = 0; layer < 2; ++layer) {
        asm volatile("" : "+s"(ws));
        ssq = (u64*)(ws + SSQ_OFF); XB = (bf16_t*)(ws + WS_XB);
        {
            pg8::SchedProj S{(const char*)XB, (const char*)(ws + WS_WIN + (size_t)layer * WS_WL1), layer, G, c};
            pg8::EpiProj E{(bf16_t*)(ws + WS_QK), (bf16_t*)(ws + WS_VT), ssq + (size_t)(2 * layer) * MTOK,
                           (layer == 0 ? 0.125f : 0.08838834764831845f) * LOG2E, 0.08838834764831845f * LOG2E, layer};
            pg8::gemm_phase(lds, DM, S, E);
        }
        GRID_BAR();
        phase_attn(p, layer, lds, tid, wave, lane);
        if (layer == 0) phase_weights(p, 1, lds, gw, NGW, wave, lane);
        GRID_BAR();
        if (layer == 1) { phase_fixup(p, gw, NGW, lane); GRID_BAR(); }
        {
            pg8::SchedPlain S{(const char*)(ws + WS_MRG), (const char*)(ws + WS_WOUT + (size_t)layer * WS_WL1), DM / 256, DM, G, c};
            pg8::EpiRes E{XB, ssq + (size_t)(2 * layer + 1) * MTOK};
            pg8::gemm_phase(lds, DM, S, E);
        }
        GRID_BAR();
        {
            pg8::SchedPlain S{(const char*)XB, (const char*)(ws + WS_W1 + (size_t)layer * WS_WL1), FF / 256, DM, G, c};
            pg8::EpiRelu2 E{(bf16_t*)(ws + WS_BIG), ssq + (size_t)(2 * layer + 1) * MTOK};
            pg8::gemm_phase(lds, DM, S, E);
        }
        GRID_BAR();
        {
            pg8::SchedPlain S{(const char*)(ws + WS_BIG), (const char*)(ws + WS_W2 + (size_t)layer * WS_WL1), DM / 256, FF, G, c};
            pg8::EpiRes E{XB, ssq + (size_t)(2 * layer + 2) * MTOK};
            pg8::gemm_phase(lds, FF, S, E);
        }
        GRID_BAR();
    }
    phase_final(p, gw, NGW, lane);
}

extern "C" void kernel_launch(void* const* d_in, const int* in_sizes, int n_in, void* d_out, int out_size, void* d_ws, size_t ws_size, hipStream_t stream) {
    static int grid = 0;
    if (grid == 0) {
        if (n_in != 13 || ws_size < WS_END) { fprintf(stderr, "kernel_launch: unexpected inputs (n_in %d, ws %zu)\n", n_in, ws_size); grid = -1; return; }
        int dev = 0, cus = 0, per_cu = 0;
        hipGetDevice(&dev); hipDeviceGetAttribute(&cus, hipDeviceAttributeMultiprocessorCount, dev);
        hipFuncSetAttribute((const void*)mega_fwd, hipFuncAttributeMaxDynamicSharedMemorySize, LDS_BYTES);
        hipOccupancyMaxActiveBlocksPerMultiprocessor(&per_cu, (const void*)mega_fwd, NWAVES * 64, LDS_BYTES);
        if (per_cu < 1) per_cu = 1;
        (void)hipGetLastError();
        grid = cus * per_cu;
    }
    if (grid < 0) return;
    hipMemsetAsync((char*)d_ws + WS_CTL, 0, CTL_BYTES, stream);
    Params p{};
    p.x = (const float*)d_in[0]; p.mem = (const float*)d_in[1]; p.g_attn = (const float*)d_in[2]; p.w_in = (const float*)d_in[3]; p.w_out = (const float*)d_in[4];
    p.lambda_qk = (const float*)d_in[5]; p.subln_g = (const float*)d_in[6]; p.g_mem = (const float*)d_in[7]; p.w_mem_kv = (const float*)d_in[8];
    p.g_mlp = (const float*)d_in[9]; p.w_mlp1 = (const float*)d_in[10]; p.w_mlp2 = (const float*)d_in[11]; p.g_final = (const float*)d_in[12];
    p.out = (float*)d_out; p.ws = (unsigned char*)d_ws;
    void* args[] = {&p};
    hipError_t e = hipLaunchCooperativeKernel((const void*)mega_fwd, dim3(grid), dim3(NWAVES * 64), args, LDS_BYTES, stream);
    if (e != hipSuccess) fprintf(stderr, "cooperative launch failed: %s (grid %d)\n", hipGetErrorString(e), grid);
}
```
